# Optimizing an MI355X kernel written in HIP

```python
import jax
import jax.numpy as jnp
from jax import lax
import numpy as np

D_MODEL = 2048
BATCH = 8
SEQ = 2048
DEPTH = 1

N_META = 16
HEAD_DIM = 128
GDN_HEADS = 8
FOX_HEADS = 8
GDN_WIDTH = GDN_HEADS * HEAD_DIM
FOX_WIDTH = FOX_HEADS * HEAD_DIM
MIX_WIDTH = GDN_WIDTH + FOX_WIDTH
CONV_WIDTH = 4
CHUNK = 64
Q_BLOCK = 128
EPS = 1e-6

IN_SPLITS = (GDN_WIDTH, GDN_WIDTH, GDN_WIDTH, GDN_WIDTH, GDN_HEADS, GDN_HEADS,
             FOX_WIDTH, FOX_WIDTH, FOX_WIDTH, FOX_WIDTH, FOX_HEADS)
IN_WIDTH = sum(IN_SPLITS)
SPLIT_POINTS = tuple(int(s) for s in np.cumsum(IN_SPLITS)[:-1])

kernel_name = 'hymba_gdn_fox_sandwich_meta'


def rmsnorm(x, w):
    xf = x.astype(jnp.float32)
    y = xf * lax.rsqrt(jnp.mean(xf * xf, axis=-1, keepdims=True) + EPS)
    return y * w.astype(jnp.float32)


def l2norm(x):
    return x * lax.rsqrt(jnp.sum(x * x, axis=-1, keepdims=True) + EPS)


def causal_depthwise_conv(x, w):
    L = x.shape[1]
    xp = jnp.pad(x, ((0, 0), (CONV_WIDTH - 1, 0), (0, 0)))
    y = xp[:, 0:L, :] * w[:, 0]
    for j in range(1, CONV_WIDTH):
        y = y + xp[:, j:j + L, :] * w[:, j]
    return y


def gdn_chunk_prep(q, k, v, beta, g):
    C = q.shape[-2]
    G = jnp.cumsum(g, axis=-1)
    causal = jnp.tril(jnp.ones((C, C), dtype=bool))
    strict = jnp.tril(jnp.ones((C, C), dtype=bool), -1)
    diff = G[..., :, None] - G[..., None, :]
    D = jnp.where(causal, jnp.exp(jnp.where(causal, diff, 0.0)), 0.0)
    kk = jnp.einsum('bhncd,bhnsd->bhncs', k, k)
    n_mat = jnp.where(strict, beta[..., :, None] * kk * D, 0.0)
    eye = jnp.eye(C, dtype=q.dtype)
    T = lax.linalg.triangular_solve(eye + n_mat, jnp.broadcast_to(eye, n_mat.shape),
                                    left_side=True, lower=True, unit_diagonal=True)
    U = jnp.einsum('bhncs,bhnsd->bhncd', T, beta[..., None] * v)
    W = jnp.einsum('bhncs,bhnsd->bhncd', T, (beta * jnp.exp(G))[..., None] * k)
    a_qk = jnp.where(causal, jnp.einsum('bhncd,bhnsd->bhncs', q, k) * D, 0.0)
    q_dec = q * jnp.exp(G)[..., None]
    k_dec = k * jnp.exp(G[..., -1:] - G)[..., None]
    chunk_decay = jnp.exp(G[..., -1])
    return (q_dec, k_dec, U, W, a_qk, chunk_decay)


def gdn_chunk_step(S, xs):
    q_dec, k_dec, U, W, a_qk, decay = xs
    v_new = U - jnp.einsum('bhcd,bhde->bhce', W, S)
    o = jnp.einsum('bhcd,bhde->bhce', q_dec, S) + jnp.einsum('bhcs,bhse->bhce', a_qk, v_new)
    S = S * decay[..., None, None] + jnp.einsum('bhcd,bhce->bhde', k_dec, v_new)
    return S, o


def gated_delta_rule(q, k, v, beta, g):
    B, H, L, d = q.shape
    n_chunks = (L - N_META) // CHUNK

    def split(t):
        meta = t[:, :, :N_META][:, :, None]
        real = t[:, :, N_META:].reshape((B, H, n_chunks, CHUNK) + t.shape[3:])
        return meta, real

    parts = [split(t) for t in (q, k, v, beta, g)]
    meta_in = gdn_chunk_prep(*[p[0] for p in parts])
    real_in = gdn_chunk_prep(*[p[1] for p in parts])
    S0 = jnp.zeros((B, H, d, d), jnp.float32)
    S, o_meta = gdn_chunk_step(S0, tuple(t[:, :, 0] for t in meta_in))
    real_xs = tuple(jnp.moveaxis(t, 2, 0) for t in real_in)
    _, o_real = lax.scan(gdn_chunk_step, S, real_xs)
    o_real = jnp.moveaxis(o_real, 0, 2).reshape(B, H, L - N_META, d)
    return jnp.concatenate([o_meta, o_real], axis=2)


def forgetting_attention(q, k, v, logf):
    L = q.shape[2]
    scale = HEAD_DIM ** -0.5
    c = jnp.cumsum(logf, axis=-1)
    starts = [0] + [N_META + i * Q_BLOCK for i in range((L - N_META) // Q_BLOCK)]
    ends = [N_META] + [N_META + (i + 1) * Q_BLOCK for i in range((L - N_META) // Q_BLOCK)]
    outs = []
    for s0, s1 in zip(starts, ends):
        qb = q[:, :, s0:s1]
        kb = k[:, :, :s1]
        vb = v[:, :, :s1]
        logits = (jnp.einsum('bhqd,bhkd->bhqk', qb, kb) * scale
                  + (c[:, :, s0:s1, None] - c[:, :, None, :s1]))
        qpos = s0 + jnp.arange(s1 - s0)
        kpos = jnp.arange(s1)
        mask = kpos[None, :] <= qpos[:, None]
        logits = jnp.where(mask, logits, -jnp.inf)
        p = jax.nn.softmax(logits, axis=-1)
        outs.append(jnp.einsum('bhqk,bhkd->bhqd', p, vb))
    return jnp.concatenate(outs, axis=2)


def hybrid_layer(h, pre_w, w_in, conv_w, a_log, dt_bias, gdn_norm_w,
                 fox_q_norm_w, fox_k_norm_w, fox_f_bias, w_out, post_w):
    B, L, _ = h.shape
    f32 = jnp.float32
    xn = rmsnorm(h, pre_w).astype(h.dtype)
    proj = xn @ w_in
    gq, gk, gv, gz, gb, ga, fq, fk, fv, fg, ff = jnp.split(proj, SPLIT_POINTS, axis=-1)

    def heads(t, n):
        return t.reshape(B, L, n, HEAD_DIM).transpose(0, 2, 1, 3)

    qkv = jax.nn.silu(causal_depthwise_conv(jnp.concatenate([gq, gk, gv], axis=-1), conv_w))
    gq, gk, gv = jnp.split(qkv.astype(f32), 3, axis=-1)
    gq = l2norm(heads(gq, GDN_HEADS)) * (HEAD_DIM ** -0.5)
    gk = l2norm(heads(gk, GDN_HEADS))
    gv = heads(gv, GDN_HEADS)
    beta = jax.nn.sigmoid(gb.astype(f32)).transpose(0, 2, 1)
    g = (-jnp.exp(a_log.astype(f32))
         * jax.nn.softplus(ga.astype(f32) + dt_bias.astype(f32))).transpose(0, 2, 1)
    o_gdn = gated_delta_rule(gq, gk, gv, beta, g)
    o_gdn = rmsnorm(o_gdn, gdn_norm_w) * jax.nn.silu(heads(gz.astype(f32), GDN_HEADS))

    fq = rmsnorm(heads(fq, FOX_HEADS), fox_q_norm_w)
    fk = rmsnorm(heads(fk, FOX_HEADS), fox_k_norm_w)
    fv = heads(fv.astype(f32), FOX_HEADS)
    logf = jax.nn.log_sigmoid(ff.astype(f32) + fox_f_bias.astype(f32)).transpose(0, 2, 1)
    o_fox = forgetting_attention(fq, fk, fv, logf) * jax.nn.silu(heads(fg.astype(f32), FOX_HEADS))

    merged = jnp.concatenate([o_gdn, o_fox], axis=1)
    merged = merged.transpose(0, 2, 1, 3).reshape(B, L, MIX_WIDTH).astype(h.dtype)
    out = merged @ w_out
    return h + rmsnorm(out, post_w).astype(h.dtype)


def setup_inputs(seed: int = 0) -> dict:
    key = jax.random.key(seed)
    ks = jax.random.split(key, 14)
    f32 = jnp.float32
    x = jax.random.normal(ks[0], (BATCH, SEQ, D_MODEL), f32)
    meta_tokens = jax.random.normal(ks[1], (N_META, D_MODEL), f32)
    pre_norm_w = 1.0 + 0.01 * jax.random.normal(ks[2], (DEPTH, D_MODEL), f32)
    w_in = jax.random.normal(ks[3], (DEPTH, D_MODEL, IN_WIDTH), f32) * (D_MODEL ** -0.5)
    conv_w = jax.random.normal(ks[4], (DEPTH, 3 * GDN_WIDTH, CONV_WIDTH), f32) * (CONV_WIDTH ** -0.5)
    a_log = jnp.log(jax.random.uniform(ks[5], (DEPTH, GDN_HEADS), f32, 1.0, 16.0))
    dt = jnp.exp(jax.random.uniform(ks[6], (DEPTH, GDN_HEADS), f32,
                                    float(np.log(1e-3)), float(np.log(1e-1))))
    dt_bias = dt + jnp.log(-jnp.expm1(-dt))
    gdn_norm_w = 1.0 + 0.01 * jax.random.normal(ks[7], (DEPTH, HEAD_DIM), f32)
    fox_q_norm_w = 1.0 + 0.01 * jax.random.normal(ks[8], (DEPTH, HEAD_DIM), f32)
    fox_k_norm_w = 1.0 + 0.01 * jax.random.normal(ks[9], (DEPTH, HEAD_DIM), f32)
    fox_f_bias = jax.random.uniform(ks[10], (DEPTH, FOX_HEADS), f32, 1.0, 4.0)
    w_out = jax.random.normal(ks[11], (DEPTH, MIX_WIDTH, D_MODEL), f32) * (MIX_WIDTH ** -0.5)
    post_norm_w = 1.0 + 0.01 * jax.random.normal(ks[12], (DEPTH, D_MODEL), f32)
    return {'x': x, 'meta_tokens': meta_tokens, 'pre_norm_w': pre_norm_w, 'w_in': w_in,
            'conv_w': conv_w, 'a_log': a_log, 'dt_bias': dt_bias, 'gdn_norm_w': gdn_norm_w,
            'fox_q_norm_w': fox_q_norm_w, 'fox_k_norm_w': fox_k_norm_w, 'fox_f_bias': fox_f_bias,
            'w_out': w_out, 'post_norm_w': post_norm_w}


def reference(x, meta_tokens, pre_norm_w, w_in, conv_w, a_log, dt_bias, gdn_norm_w,
              fox_q_norm_w, fox_k_norm_w, fox_f_bias, w_out, post_norm_w):
    B = x.shape[0]
    meta = jnp.broadcast_to(meta_tokens.astype(x.dtype)[None], (B, N_META, x.shape[-1]))
    h = jnp.concatenate([meta, x], axis=1)
    for l in range(DEPTH):
        h = hybrid_layer(h, pre_norm_w[l], w_in[l], conv_w[l], a_log[l], dt_bias[l],
                         gdn_norm_w[l], fox_q_norm_w[l], fox_k_norm_w[l], fox_f_bias[l],
                         w_out[l], post_norm_w[l])
    return h[:, N_META:]
```

```cpp
#include <hip/hip_runtime.h>
#include <hip/hip_cooperative_groups.h>
#include <cstdio>
namespace cg = cooperative_groups;

#define DI __device__ __forceinline__
#define LAS __attribute__((address_space(3)))
typedef float f32x16 __attribute__((ext_vector_type(16)));
typedef short s16x4 __attribute__((ext_vector_type(4)));
typedef unsigned u32x2 __attribute__((ext_vector_type(2)));

namespace pg8 {
#define PG8_LAS __attribute__((address_space(3)))
typedef unsigned short bf16_t;
typedef short bf16x8 __attribute__((ext_vector_type(8)));
typedef float f32x4 __attribute__((ext_vector_type(4)));
typedef unsigned u32x4 __attribute__((ext_vector_type(4)));
constexpr int BM = 256, BK = 64, HALF = 128, HTB = HALF * BK * 2  , STAGE_BYTES = 8 * HTB, NXCD = 8, WGM = 8;

__host__ __device__ __forceinline__ int lds_byte(int r, int c) { const int st = (r >> 4) * 2 + (c >> 5), rr = r & 15, cc = c & 31, ob = rr * 64 + cc * 2; return st * 1024 + (ob ^ (((ob >> 9) & 1) << 5)); }
__host__ __device__ __forceinline__ void stage_rc(int b, int& R, int& C) { const int st = b / 1024, sb = b % 1024, swz = sb ^ (((sb >> 9) & 1) << 5); R = (st >> 1) * 16 + swz / 64; C = (st & 1) * 32 + (swz % 64) / 2; }
__host__ __device__ __forceinline__ int perm32(int rho) { const int n = rho >> 4, i = rho & 15; return 8 * (i >> 2) + 4 * n + (i & 3); }

struct Unit { int pm, pn; };
struct Gemm { const bf16_t* A; const bf16_t* Bt; int M, N, K; };

struct StaticOrder {
    int nM, nN, nwg, G, c;
    __host__ __device__ void init(int M, int N, int G_, int c_) { nM = M / BM; nN = N / BM; nwg = nM * nN; G = G_; c = c_; }
    __host__ __device__ bool next(int i, Unit& u) const {
        const long L = (long)i * G + c; if (L >= nwg) return false;
        int wgid = (int)L; { const int q = nwg / NXCD, r = nwg % NXCD, xcd = wgid % NXCD, off = wgid / NXCD; wgid = (xcd < r ? xcd * (q + 1) : r * (q + 1) + (xcd - r) * q) + off; }
        const int nig = WGM * nN, gid = wgid / nig, fm = gid * WGM, gsz = (nM - fm) < WGM ? (nM - fm) : WGM;
        u.pm = fm + ((wgid % nig) % gsz); u.pn = (wgid % nig) / gsz; return true;
    }
    __device__ __forceinline__ void a_ready(const Unit&) const {}
    __device__ __forceinline__ void done(const Unit&) const {}
};
typedef unsigned u32x4 __attribute__((ext_vector_type(4)));
template <class Epi, class Sched, bool ALIGN_EPI = false, bool SP2 = false>
__device__ __forceinline__ void gemm_phase(PG8_LAS unsigned char* lds, const Gemm g, const Sched& S, const Epi& E, const int tid) {
    const int wid = __builtin_amdgcn_readfirstlane(tid >> 6), lane = tid & 63, wr = wid >> 2, wc = wid & 3, fr = lane & 15, fq = lane >> 4;
    const int K = g.K, nt = K / BK;
    unsigned voffA[2], voffB[2];
#pragma unroll
    for (int i = 0; i < 2; ++i) { int R, C; stage_rc(tid * 16 + i * 8192, R, C); const int Rb = Epi::PERM ? ((R & ~31) + perm32(R & 31)) : R;
        voffA[i] = (unsigned)(R * K + C) * 2u; voffB[i] = (unsigned)(Rb * K + C) * 2u; }
    const size_t kstep = (size_t)(BK * 2);
    const size_t hstep = (size_t)HALF * K * 2;
    const size_t tstep = 2 * hstep;
    const unsigned ldsw = (unsigned)wid * 1024u;
    const int aoff = lds_byte(wr * 64 + fr, fq * 8), boff = lds_byte(wc * 32 + fr, fq * 8);
#define PG8_SA(b, h) (((b) * 2 + (h)) * HTB)
#define PG8_SB(b, h) ((4 + (b) * 2 + (h)) * HTB)
#define PG8_STAGE(bufoff, gbase, voff) do { _Pragma("unroll") for (int _i = 0; _i < 2; ++_i) \
        __builtin_amdgcn_global_load_lds((const unsigned*)((const char*)(gbase) + (voff)[_i]), (PG8_LAS unsigned*)(lds + (bufoff) + ldsw + _i * 8192), 16, 0, 0); } while (0)
#define PG8_LDA(dst, b, h) do { _Pragma("unroll") for (int m = 0; m < 4; ++m) _Pragma("unroll") for (int k = 0; k < 2; ++k) dst[m][k] = *(const PG8_LAS bf16x8*)(lds + PG8_SA(b, h) + aoff + m * 2048 + k * 1024); } while (0)
#define PG8_LDB(dst, b, h) do { _Pragma("unroll") for (int n = 0; n < 2; ++n) _Pragma("unroll") for (int k = 0; k < 2; ++k) dst[n][k] = *(const PG8_LAS bf16x8*)(lds + PG8_SB(b, h) + boff + n * 2048 + k * 1024); } while (0)
#define PG8_MMA(ai, bj, At, Bt) do { __builtin_amdgcn_s_setprio(1); _Pragma("unroll") for (int m = 0; m < 4; ++m) _Pragma("unroll") for (int n = 0; n < 2; ++n) _Pragma("unroll") for (int k = 0; k < 2; ++k) \
        acc[ai][bj][m][n] = __builtin_amdgcn_mfma_f32_16x16x32_bf16(Bt[n][k], At[m][k], acc[ai][bj][m][n], 0, 0, 0); __builtin_amdgcn_s_setprio(0); } while (0)
#define PG8_WAIT_V(n) asm volatile("s_waitcnt vmcnt(" #n ")" ::: "memory")
#define PG8_WAIT_L(n) asm volatile("s_waitcnt lgkmcnt(" #n ")" ::: "memory")
#define PG8_BAR __builtin_amdgcn_s_barrier()
#define PG8_SCHED __builtin_amdgcn_sched_barrier(0)
    Unit cur, nxt; int ui = 0;
    if (!S.next(0, cur)) return;
    f32x4 acc[2][2][4][2];
#pragma unroll
    for (int a = 0; a < 2; ++a)
#pragma unroll
        for (int b = 0; b < 2; ++b)
#pragma unroll
            for (int m = 0; m < 4; ++m)
#pragma unroll
                for (int n = 0; n < 2; ++n) acc[a][b][m][n] = (f32x4){0.f, 0.f, 0.f, 0.f};
    bf16x8 At[4][2], B0[2][2], B1[2][2];
    const char* cA = (const char*)g.A + (size_t)cur.pm * tstep; const char* cB = (const char*)g.Bt + (size_t)cur.pn * tstep;
    S.a_ready(cur);
    if constexpr (SP2) {
        PG8_STAGE(PG8_SB(0, 0), cB, voffB); PG8_STAGE(PG8_SB(0, 1), cB + hstep, voffB); PG8_STAGE(PG8_SA(0, 0), cA, voffA); PG8_STAGE(PG8_SA(0, 1), cA + hstep, voffA);
        if (wr == 1) PG8_BAR;
        PG8_WAIT_V(2); PG8_BAR;
        PG8_STAGE(PG8_SB(1, 0), cB + kstep, voffB); PG8_STAGE(PG8_SA(1, 0), cA + kstep, voffA); PG8_STAGE(PG8_SB(1, 1), cB + hstep + kstep, voffB);
        PG8_WAIT_V(6); PG8_BAR;
    } else {
        PG8_STAGE(PG8_SB(0, 0), cB, voffB); PG8_STAGE(PG8_SA(0, 0), cA, voffA); PG8_STAGE(PG8_SB(0, 1), cB + hstep, voffB); PG8_STAGE(PG8_SA(0, 1), cA + hstep, voffA);
        if (wr == 1) PG8_BAR;
        PG8_WAIT_V(4); PG8_BAR;
        PG8_STAGE(PG8_SB(1, 0), cB + kstep, voffB); PG8_STAGE(PG8_SA(1, 0), cA + kstep, voffA); PG8_STAGE(PG8_SB(1, 1), cB + hstep + kstep, voffB);
        PG8_WAIT_V(6); PG8_BAR;
    }
    for (;;) {
        const bool has_next = S.next(ui + 1, nxt);
        const char* nA = has_next ? (const char*)g.A + (size_t)nxt.pm * tstep : cA; const char* nB = has_next ? (const char*)g.Bt + (size_t)nxt.pn * tstep : cB;
        for (int t = 0; t < nt; t += 2) {
            const bool last = (t == nt - 2);
            const char* a1 = cA + (size_t)(t + 1) * kstep;
            const char* a2 = last ? nA : cA + (size_t)(t + 2) * kstep; const char* b2 = last ? nB : cB + (size_t)(t + 2) * kstep;
            const char* a3 = a2 + kstep; const char* b3 = b2 + kstep;
            if (last && has_next) S.a_ready(nxt);
            if constexpr (SP2) {
            PG8_LDB(B0, 0, 0); PG8_LDB(B1, 0, 1); PG8_SCHED; PG8_LDA(At, 0, 0); PG8_STAGE(PG8_SA(1, 1), a1 + hstep, voffA);
            PG8_WAIT_V(8); PG8_WAIT_L(0); PG8_BAR; PG8_MMA(0, 0, At, B0); PG8_MMA(0, 1, At, B1); PG8_BAR; PG8_SCHED;
            PG8_LDA(At, 0, 1); PG8_STAGE(PG8_SB(0, 0), b2, voffB); PG8_STAGE(PG8_SB(0, 1), b2 + hstep, voffB); PG8_STAGE(PG8_SA(0, 0), a2, voffA);
            PG8_WAIT_V(8); PG8_WAIT_L(0); PG8_BAR; PG8_MMA(1, 0, At, B0); PG8_MMA(1, 1, At, B1); PG8_BAR; PG8_SCHED;
            PG8_LDB(B0, 1, 0); PG8_LDB(B1, 1, 1); PG8_SCHED; PG8_LDA(At, 1, 0); PG8_STAGE(PG8_SA(0, 1), a2 + hstep, voffA);
            PG8_WAIT_V(8); PG8_WAIT_L(0); PG8_BAR; PG8_MMA(0, 0, At, B0); PG8_MMA(0, 1, At, B1); PG8_BAR; PG8_SCHED;
            PG8_LDA(At, 1, 1); PG8_STAGE(PG8_SB(1, 0), b3, voffB); PG8_STAGE(PG8_SB(1, 1), b3 + hstep, voffB); PG8_STAGE(PG8_SA(1, 0), a3, voffA);
            PG8_WAIT_V(8); PG8_WAIT_L(0); PG8_BAR; PG8_MMA(1, 0, At, B0); PG8_MMA(1, 1, At, B1); PG8_BAR; PG8_SCHED;
            } else {
            PG8_LDB(B0, 0, 0); PG8_SCHED; PG8_LDA(At, 0, 0); PG8_STAGE(PG8_SA(1, 1), a1 + hstep, voffA);
            PG8_WAIT_L(8); PG8_BAR; PG8_WAIT_L(0); PG8_MMA(0, 0, At, B0); PG8_BAR; PG8_SCHED;
            PG8_LDB(B1, 0, 1); PG8_STAGE(PG8_SB(0, 0), b2, voffB);
            PG8_BAR; PG8_WAIT_L(0); PG8_MMA(0, 1, At, B1); PG8_BAR;
            PG8_LDA(At, 0, 1); PG8_STAGE(PG8_SA(0, 0), a2, voffA);
            PG8_BAR; PG8_WAIT_L(0); PG8_MMA(1, 0, At, B0); PG8_BAR; PG8_SCHED;
            PG8_STAGE(PG8_SB(0, 1), b2 + hstep, voffB);
            PG8_WAIT_V(6); PG8_BAR; PG8_MMA(1, 1, At, B1); PG8_BAR;
            PG8_LDB(B0, 1, 0); PG8_SCHED; PG8_LDA(At, 1, 0); PG8_STAGE(PG8_SA(0, 1), a2 + hstep, voffA);
            PG8_WAIT_L(8); PG8_BAR; PG8_WAIT_L(0); PG8_MMA(0, 0, At, B0); PG8_BAR; PG8_SCHED;
            PG8_LDB(B1, 1, 1); PG8_STAGE(PG8_SB(1, 0), b3, voffB);
            PG8_BAR; PG8_WAIT_L(0); PG8_MMA(0, 1, At, B1); PG8_BAR;
            PG8_LDA(At, 1, 1); PG8_STAGE(PG8_SA(1, 0), a3, voffA);
            PG8_BAR; PG8_WAIT_L(0); PG8_MMA(1, 0, At, B0); PG8_BAR; PG8_SCHED;
            PG8_STAGE(PG8_SB(1, 1), b3 + hstep, voffB);
            PG8_WAIT_V(6); PG8_BAR; PG8_MMA(1, 1, At, B1); PG8_BAR;
            }
        }
        if constexpr (ALIGN_EPI) { if (wr == 0) PG8_BAR; }
        if constexpr (!Epi::AFTER_DRAIN) { E(acc, cur, wr, wc, fr, fq); S.done(cur); }
        if (!has_next) break;
#pragma unroll
        for (int a = 0; a < 2; ++a)
#pragma unroll
            for (int b = 0; b < 2; ++b)
#pragma unroll
                for (int m = 0; m < 4; ++m)
#pragma unroll
                    for (int n = 0; n < 2; ++n) acc[a][b][m][n] = (f32x4){0.f, 0.f, 0.f, 0.f};
        cur = nxt; cA = nA; cB = nB; ++ui;
        if constexpr (ALIGN_EPI) { if (wr == 1) PG8_BAR; }
    }
    PG8_WAIT_V(0);
    if constexpr (!ALIGN_EPI) { if (wr == 0) PG8_BAR; }
    PG8_BAR;
    if constexpr (Epi::AFTER_DRAIN) { E.fused(acc, cur, wr, wc, fr, fq, lds, wid, lane); S.done(cur); }
#undef PG8_SA
#undef PG8_SB
#undef PG8_STAGE
#undef PG8_LDA
#undef PG8_LDB
#undef PG8_MMA
#undef PG8_WAIT_V
#undef PG8_WAIT_L
#undef PG8_BAR
#undef PG8_SCHED
}
}
using pg8::bf16_t; using pg8::bf16x8; using pg8::f32x4; using pg8::u32x4;

constexpr int NB = 8, SEQ = 2048, DM = 2048, NMETA = 16, LTOT = 2064, HD = 128, NH = 8;
constexpr int MR = NB * SEQ;
constexpr int MPAD = 16640;
constexpr int NWIDE = 8192, NPAD = 8448;
constexpr int NCH = 33;
constexpr int LP = 2112;
constexpr int COL_GQ = 0, COL_GK = 1024, COL_GV = 2048, COL_GZ = 3072, COL_FQ = 4096, COL_FK = 5120, COL_FV = 6144, COL_FG = 7168;
constexpr float EPSF = 1e-6f;
constexpr float LOG2E = 1.4426950408889634f;

constexpr size_t MiB = 1024 * 1024;
constexpr size_t WS_XN = 0;
constexpr size_t WS_WINT = 65 * MiB;
constexpr size_t WS_U = 0;
constexpr size_t WS_W = 33 * MiB;
constexpr size_t WS_WOUTT = 104 * MiB;
constexpr size_t WS_PROJ = 112 * MiB;
constexpr size_t WS_OUT = 112 * MiB;
constexpr size_t WS_NARROW = 372 * MiB;
constexpr size_t WS_RK = 375 * MiB;
constexpr size_t WS_FK = 376 * MiB;
constexpr size_t WS_FVT = 408 * MiB;
constexpr size_t WS_KDT = 441 * MiB;
constexpr size_t WS_C2 = 474 * MiB;
constexpr size_t WS_DECAY = 475 * MiB;
constexpr size_t WS_CTR = 476 * MiB;
constexpr size_t WS_BAR = 476 * MiB + 65536;
constexpr size_t WS_END = 477 * MiB;
constexpr size_t DO_MERGED = 0, DO_QD = 64 * MiB, DO_AQK = 97 * MiB;
#ifndef REP1
#define REP1 1
#endif
#ifndef REP2
#define REP2 1
#endif
#ifndef REP3
#define REP3 1
#endif
constexpr int LDS_BYTES = 156160;
constexpr int L_QW = 155136;

struct Params {
    const float* x; const float* meta; const float* pre_w; const float* w_in; const float* conv_w; const float* a_log; const float* dt_bias;
    const float* gdn_norm_w; const float* fq_w; const float* fk_w; const float* f_bias; const float* w_out; const float* post_w;
    float* out; unsigned char* ws;
};

typedef __bf16 bf16n2 __attribute__((ext_vector_type(2)));
typedef float f32x2 __attribute__((ext_vector_type(2)));
DI unsigned pk2(float lo, float hi) { const f32x2 v = {lo, hi}; return __builtin_bit_cast(unsigned, __builtin_convertvector(v, bf16n2)); }
DI unsigned f2bf(float x) { return pk2(x, 0.f) & 0xffffu; }
DI float bflo(unsigned u) { return __uint_as_float(u << 16); }
DI float bfhi(unsigned u) { return __uint_as_float(u & 0xffff0000u); }
DI float bf2f(bf16_t b) { return __uint_as_float(((unsigned)b) << 16); }
DI float wave_sum(float v);
template <int CTRL> DI float dppf(float x) { return __int_as_float(__builtin_amdgcn_update_dpp(0, __float_as_int(x), CTRL, 0xf, 0xf, true)); }
DI float sum4_dpp(float x) { x += dppf<0xB1>(x); x += dppf<0x4E>(x); return x; }
DI float sum16_dpp(float x) { x = sum4_dpp(x); x += dppf<0x141>(x); x += dppf<0x140>(x); return x; }
DI float xhalf_max(float x) { const u32x2 rr = __builtin_amdgcn_permlane32_swap(__float_as_uint(x), __float_as_uint(x), false, false); return fmaxf(__uint_as_float(rr[0]), __uint_as_float(rr[1])); }
DI float xhalf_sum(float x) { const u32x2 rr = __builtin_amdgcn_permlane32_swap(__float_as_uint(x), __float_as_uint(x), false, false); return __uint_as_float(rr[0]) + __uint_as_float(rr[1]); }
template <int CTRL, int RM, bool BC> DI float dppx(float x) { return __int_as_float(__builtin_amdgcn_update_dpp(0, __float_as_int(x), CTRL, RM, 0xf, BC)); }
DI float scan64_dpp(float v) {
    v += dppx<0x111, 0xf, true>(v); v += dppx<0x112, 0xf, true>(v); v += dppx<0x114, 0xf, true>(v); v += dppx<0x118, 0xf, true>(v);
    v += dppx<0x142, 0xa, false>(v); v += dppx<0x143, 0xc, false>(v); return v; }
DI float lane_bcast(float x, int l) { return __int_as_float(__builtin_amdgcn_readlane(__float_as_int(x), l)); }
DI float wave_sum(float v) { v = sum16_dpp(v); return (lane_bcast(v, 0) + lane_bcast(v, 16)) + (lane_bcast(v, 32) + lane_bcast(v, 48)); }
DI float sigmoidf_(float x) { return __builtin_amdgcn_rcpf(1.f + __expf(-x)); }
DI float siluf_(float x) { return x * __builtin_amdgcn_rcpf(1.f + __expf(-x)); }
DI float softplusf_(float x) { return x > 20.f ? x : __logf(1.f + __expf(x)); }
DI int rowof(int b, int p) { return p < NMETA ? MR + p : b * SEQ + (p - NMETA); }
DI int crow(int t, int hh) { return (t & 3) + 8 * (t >> 2) + 4 * hh; }
DI bf16x8 pack8(const f32x16& x, int s) {
    u32x4 p;
    p[0] = pk2(x[8 * s + 0], x[8 * s + 1]); p[1] = pk2(x[8 * s + 2], x[8 * s + 3]); p[2] = pk2(x[8 * s + 4], x[8 * s + 5]); p[3] = pk2(x[8 * s + 6], x[8 * s + 7]);
    return __builtin_bit_cast(bf16x8, p);
}
#define LDS_BARRIER() do { asm volatile("s_waitcnt lgkmcnt(0)" ::: "memory"); __builtin_amdgcn_s_barrier(); asm volatile("" ::: "memory"); } while (0)
#define CB() asm volatile("" ::: "memory")
#define MFMA32(a, b, c) __builtin_amdgcn_mfma_f32_32x32x16_bf16((a), (b), (c), 0, 0, 0)
DI bf16x8 ldfrag_perm(const bf16_t* rowp, int k0, int hh) {
    const u32x2 a = *(const u32x2*)(rowp + k0 + 4 * hh), b = *(const u32x2*)(rowp + k0 + 8 + 4 * hh);
    u32x4 p; p[0] = a[0]; p[1] = a[1]; p[2] = b[0]; p[3] = b[1];
    return __builtin_bit_cast(bf16x8, p);
}
struct EpiProj {
    static constexpr bool PERM = true, AFTER_DRAIN = false;
    bf16_t* P; float* narrow;
    DI void operator()(const f32x4 (&acc)[2][2][4][2], const pg8::Unit& u, int wr, int wc, int fr, int fq) const {
        const int row0 = u.pm * 256 + wr * 64 + fr;
        if (u.pn < 32) {
            const int col0 = u.pn * 256 + wc * 32 + 8 * fq;
            const bool gate = (u.pn >= 12 && u.pn < 16) || (u.pn >= 28);
#pragma unroll
            for (int ai = 0; ai < 2; ++ai)
#pragma unroll
                for (int m = 0; m < 4; ++m) { bf16_t* rowp = P + (size_t)(row0 + ai * 128 + m * 16) * NWIDE + col0;
#pragma unroll
                    for (int bj = 0; bj < 2; ++bj) { f32x4 v0 = acc[ai][bj][m][0], v1 = acc[ai][bj][m][1];
                        if (gate) {
#pragma unroll
                            for (int e = 0; e < 4; ++e) { v0[e] = siluf_(v0[e]); v1[e] = siluf_(v1[e]); } }
                        u32x4 w; w.x = pk2(v0[0], v0[1]); w.y = pk2(v0[2], v0[3]); w.z = pk2(v1[0], v1[1]); w.w = pk2(v1[2], v1[3]);
                        *(u32x4*)(rowp + bj * 128) = w; } }
        } else if (wc == 0) {
#pragma unroll
            for (int ai = 0; ai < 2; ++ai)
#pragma unroll
                for (int m = 0; m < 4; ++m) { float* rp = narrow + (size_t)(row0 + ai * 128 + m * 16) * 32 + 8 * fq;
                    *(f32x4*)rp = acc[ai][0][m][0]; *(f32x4*)(rp + 4) = acc[ai][0][m][1]; }
        }
    }
};
struct EpiOut {
    static constexpr bool PERM = true, AFTER_DRAIN = false;
    bf16_t* C;
    DI void operator()(const f32x4 (&acc)[2][2][4][2], const pg8::Unit& u, int wr, int wc, int fr, int fq) const {
        const int row0 = u.pm * 256 + wr * 64 + fr, col0 = u.pn * 256 + wc * 32 + 8 * fq;
#pragma unroll
        for (int ai = 0; ai < 2; ++ai)
#pragma unroll
            for (int m = 0; m < 4; ++m) { bf16_t* rowp = C + (size_t)(row0 + ai * 128 + m * 16) * DM + col0;
#pragma unroll
                for (int bj = 0; bj < 2; ++bj) { const f32x4 v0 = acc[ai][bj][m][0], v1 = acc[ai][bj][m][1];
                    u32x4 w; w.x = pk2(v0[0], v0[1]); w.y = pk2(v0[2], v0[3]); w.z = pk2(v1[0], v1[1]); w.w = pk2(v1[2], v1[3]);
                    *(u32x4*)(rowp + bj * 128) = w; } }
    }
};

DI void p0_rmsnorm_rows(const Params& p, int gw, int ngw, int lane) {
    bf16_t* xn = (bf16_t*)(p.ws + WS_XN);
    f32x4 w[8];
#pragma unroll
    for (int j = 0; j < 8; ++j) w[j] = ((const f32x4*)p.pre_w)[lane + 64 * j];
    f32x4 v[8], vnx[8];
    int row = gw;
    if (row < MR + NMETA) { const float* src = row < MR ? p.x + (size_t)row * DM : p.meta + (size_t)(row - MR) * DM;
#pragma unroll
        for (int j = 0; j < 8; ++j) v[j] = __builtin_nontemporal_load((const f32x4*)src + lane + 64 * j); }
    for (; row < MR + NMETA; row += ngw) {
        const int nrow = row + ngw;
        if (nrow < MR + NMETA) { const float* src = nrow < MR ? p.x + (size_t)nrow * DM : p.meta + (size_t)(nrow - MR) * DM;
#pragma unroll
            for (int j = 0; j < 8; ++j) vnx[j] = __builtin_nontemporal_load((const f32x4*)src + lane + 64 * j); }
        float ss = 0.f;
#pragma unroll
        for (int j = 0; j < 8; ++j) ss += v[j][0] * v[j][0] + v[j][1] * v[j][1] + v[j][2] * v[j][2] + v[j][3] * v[j][3];
        ss = wave_sum(ss);
        const float rstd = rsqrtf(ss * (1.f / DM) + EPSF);
#pragma unroll
        for (int j = 0; j < 8; ++j) {
            u32x2 o; o[0] = pk2(v[j][0] * rstd * w[j][0], v[j][1] * rstd * w[j][1]); o[1] = pk2(v[j][2] * rstd * w[j][2], v[j][3] * rstd * w[j][3]);
            *(u32x2*)(xn + (size_t)row * DM + 4 * (lane + 64 * j)) = o; }
#pragma unroll
        for (int j = 0; j < 8; ++j) v[j] = vnx[j];
    }
}
DI int remap_in_col(int c) {
    if (c < 4096) return c;
    if (c < 4112) return NWIDE + (c - 4096);
    if (c < 8208) return c - 16;
    return NWIDE + 16 + (c - 8208);
}
DI void p0_transpose_item(const float* src, int ncols, int k0, int n0, bf16_t* dst, bool remap, LAS float* scr, int lane) {
    const int col = n0 + (lane & 31);
    float v[32];
#pragma unroll
    for (int i = 0; i < 32; ++i) { const int kk = 2 * i + (lane >> 5); v[i] = col < ncols ? __builtin_nontemporal_load(src + (size_t)(k0 + kk) * ncols + col) : 0.f; }
#pragma unroll
    for (int i = 0; i < 32; ++i) { const int kk = 2 * i + (lane >> 5); scr[kk * 33 + (lane & 31)] = v[i]; }
    CB();
    const int c = lane & 7;
#pragma unroll
    for (int j = 0; j < 4; ++j) { const int n = (lane >> 3) + 8 * j, cc = n0 + n; const LAS float* t = scr + (8 * c) * 33 + n;
        u32x4 o; o.x = pk2(t[0], t[33]); o.y = pk2(t[2 * 33], t[3 * 33]); o.z = pk2(t[4 * 33], t[5 * 33]); o.w = pk2(t[6 * 33], t[7 * 33]);
        if (cc < ncols) *(u32x4*)(dst + (size_t)(remap ? remap_in_col(cc) : cc) * 2048 + k0 + 8 * c) = o; }
    CB();
}
DI void phase0(const Params& p, LAS unsigned char* lds, int tid, int wid, int lane) {
    if (blockIdx.x == 0 && tid < 64) ((unsigned*)(p.ws + WS_CTR))[tid] = 0u;
    const int gw = blockIdx.x * 8 + wid, ngw = gridDim.x * 8;
    p0_rmsnorm_rows(p, gw, ngw, lane);
    constexpr int NB_IN = (8216 + 31) / 32;
    constexpr int I_IN = 32 * NB_IN, I_OUT = 32 * 64;
    LAS float* scr = (LAS float*)lds + wid * (64 * 33);
    for (int it = gw; it < I_IN + I_OUT; it += ngw) {
        if (it < I_IN) p0_transpose_item(p.w_in, 8216, 64 * (it / NB_IN), 32 * (it % NB_IN), (bf16_t*)(p.ws + WS_WINT), true, scr, lane);
        else { const int u = it - I_IN; p0_transpose_item(p.w_out, 2048, 64 * (u >> 6), 32 * (u & 63), (bf16_t*)(p.ws + WS_WOUTT), false, scr, lane); }
    }
}
constexpr int L_QH = 0, L_KH = 17408, L_VB = 34816, L_KB = 52224, L_NM = 69632, L_TM = 87040, L_GS = 96256, L_BS = 96512;
DI bf16x8 tr_pair(const LAS unsigned char* lo, const LAS unsigned char* hi) {
    const s16x4 a = __builtin_amdgcn_ds_read_tr16_b64_v4i16((LAS s16x4*)lo), b = __builtin_amdgcn_ds_read_tr16_b64_v4i16((LAS s16x4*)hi);
    return __builtin_shufflevector(a, b, 0, 1, 2, 3, 4, 5, 6, 7);
}
DI bf16x8 ldsfrag_perm(const LAS unsigned char* rowp, int k0, int hh) {
    const u32x2 a = *(const LAS u32x2*)(rowp + 2 * (k0 + 4 * hh)), b = *(const LAS u32x2*)(rowp + 2 * (k0 + 8 + 4 * hh));
    u32x4 p; p[0] = a[0]; p[1] = a[1]; p[2] = b[0]; p[3] = b[1];
    return __builtin_bit_cast(bf16x8, p);
}
struct PrepRegs { u32x4 xr[11]; f32x4 w[8]; u32x4 fkv[2]; float pn0, pn1; };
DI void prep_loads(const Params& p, int task, int tid, int wid, int lane, PrepRegs& R) {
    const int bh = task / NCH, ch = task % NCH, b = bh >> 3, h = bh & 7;
    const bf16_t* proj = (const bf16_t*)(p.ws + WS_PROJ); const float* narrow = (const float*)(p.ws + WS_NARROW);
    const int nvalid = ch == 0 ? NMETA : 64, pbase = ch == 0 ? 0 : NMETA + 64 * (ch - 1);
    const int cgp = tid & 15, seg = (tid >> 4) & 7, m = __builtin_amdgcn_readfirstlane(tid >> 7);
    const int ch0 = m * 1024 + h * 128 + cgp * 8;
    if (m < 3) {
#pragma unroll
        for (int e = 0; e < 8; ++e) R.w[e] = *(const f32x4*)(p.conv_w + (size_t)(ch0 + e) * 4);
#pragma unroll
        for (int j = 0; j < 11; ++j) { const int i = 8 * seg - 3 + j, pp = pbase + i;
            R.xr[j] = (u32x4){0u, 0u, 0u, 0u};
            if (pp >= 0 && i < nvalid) R.xr[j] = *(const u32x4*)(proj + (size_t)rowof(b, pp) * NWIDE + ch0); }
    }
#pragma unroll
    for (int it = 0; it < 2; ++it) { const int item = tid + 512 * it, i = item >> 4;
        R.fkv[it] = (u32x4){0u, 0u, 0u, 0u};
        if (i < nvalid) R.fkv[it] = *(const u32x4*)(proj + (size_t)rowof(b, pbase + i) * NWIDE + COL_FK + h * 128 + (item & 15) * 8); }
    R.pn0 = 0.f; R.pn1 = 0.f;
    if (wid == 0 && lane < nvalid) { const float* nr = narrow + (size_t)rowof(b, pbase + lane) * 32; R.pn0 = nr[h]; R.pn1 = nr[8 + h]; }
}
DI void gdn_prep_task(const Params& p, LAS unsigned char* lds, int task, int next_task, int tid, int wid, int lane, PrepRegs& R) {
    const int bh = task / NCH, ch = task % NCH, b = bh >> 3, h = bh & 7;
    const size_t cb = (size_t)bh * NCH + ch;
    bf16_t* Ug = (bf16_t*)(p.ws + WS_U); bf16_t* Wg = (bf16_t*)(p.ws + WS_W); bf16_t* kdg = (bf16_t*)(p.ws + WS_KDT);
    bf16_t* qdg = (bf16_t*)((unsigned char*)p.out + DO_QD); bf16_t* aqkg = (bf16_t*)((unsigned char*)p.out + DO_AQK);
    LAS float* Nm = (LAS float*)(lds + L_NM); LAS bf16_t* Tm = (LAS bf16_t*)(lds + L_TM); LAS float* Gs = (LAS float*)(lds + L_GS); LAS float* Bs = (LAS float*)(lds + L_BS);
    const int nvalid = ch == 0 ? NMETA : 64, pbase = ch == 0 ? 0 : NMETA + 64 * (ch - 1);
    const int cgp = tid & 15, seg = (tid >> 4) & 7, m = __builtin_amdgcn_readfirstlane(tid >> 7);
    if (wid == 0) {
        float beta = 0.f, g = 0.f;
        if (lane < nvalid) { beta = sigmoidf_(R.pn0); g = -__expf(p.a_log[h]) * softplusf_(R.pn1 + p.dt_bias[h]); }
        const float G = scan64_dpp(g);
        Gs[lane] = G; Bs[lane] = beta;
    }
    __syncthreads();
    const float Gl = Gs[63];
    if (tid == 0) ((float*)(p.ws + WS_DECAY))[cb] = __expf(Gl);
#pragma unroll
    for (int it = 0; it < 2; ++it) { const int item = tid + 512 * it, i = item >> 4;
        float ss = 0.f;
#pragma unroll
        for (int e2 = 0; e2 < 4; ++e2) { const float lo = bflo(R.fkv[it][e2]), hi = bfhi(R.fkv[it][e2]); ss += lo * lo + hi * hi; }
        ss = sum16_dpp(ss);
        if ((item & 15) == 0 && i < nvalid) ((float*)(p.ws + WS_RK))[(size_t)bh * LP + pbase + i] = rsqrtf(ss * (1.f / HD) + EPSF); }
    if (m < 3) {
        float Gv[8], Bv[8];
        { const f32x4 g0 = *(const LAS f32x4*)(Gs + 8 * seg), g1 = *(const LAS f32x4*)(Gs + 8 * seg + 4), b0 = *(const LAS f32x4*)(Bs + 8 * seg), b1 = *(const LAS f32x4*)(Bs + 8 * seg + 4);
#pragma unroll
          for (int e = 0; e < 4; ++e) { Gv[e] = g0[e]; Gv[4 + e] = g1[e]; Bv[e] = b0[e]; Bv[4 + e] = b1[e]; } }
        float xf[11][8];
#pragma unroll
        for (int j = 0; j < 11; ++j)
#pragma unroll
            for (int e2 = 0; e2 < 4; ++e2) { xf[j][2 * e2] = bflo(R.xr[j][e2]); xf[j][2 * e2 + 1] = bfhi(R.xr[j][e2]); }
#pragma unroll
        for (int u = 0; u < 8; ++u) {
            const int i = 8 * seg + u;
            float y[8];
#pragma unroll
            for (int e = 0; e < 8; ++e) y[e] = 0.f;
#pragma unroll
            for (int j = 0; j < 4; ++j)
#pragma unroll
                for (int e = 0; e < 8; ++e) y[e] += xf[u + j][e] * R.w[e][j];
            if (i >= nvalid) {
#pragma unroll
                for (int e = 0; e < 8; ++e) y[e] = 0.f;
            }
#pragma unroll
            for (int e = 0; e < 8; ++e) y[e] = siluf_(y[e]);
            const float Gi = Gv[u], bi = Bv[u];
            if (m < 2) {
                float ss = 0.f;
#pragma unroll
                for (int e = 0; e < 8; ++e) ss += y[e] * y[e];
                ss = sum16_dpp(ss);
                const float rn = rsqrtf(ss + EPSF) * (m == 0 ? 0.08838834764831845f : 1.f);
#pragma unroll
                for (int e = 0; e < 8; ++e) y[e] *= rn;
            }
            u32x4 o; o.x = pk2(y[0], y[1]); o.y = pk2(y[2], y[3]); o.z = pk2(y[4], y[5]); o.w = pk2(y[6], y[7]);
            if (m == 0) {
                *(LAS u32x4*)(lds + L_QH + i * 272 + cgp * 16) = o;
                const float eg = __expf(Gi);
                o.x = pk2(y[0] * eg, y[1] * eg); o.y = pk2(y[2] * eg, y[3] * eg); o.z = pk2(y[4] * eg, y[5] * eg); o.w = pk2(y[6] * eg, y[7] * eg);
                *(u32x4*)(qdg + cb * 8192 + i * 128 + cgp * 8) = o;
            } else if (m == 1) {
                *(LAS u32x4*)(lds + L_KH + i * 272 + cgp * 16) = o;
                const float f1 = bi * __expf(Gi), f2 = __expf(Gl - Gi);
                o.x = pk2(y[0] * f1, y[1] * f1); o.y = pk2(y[2] * f1, y[3] * f1); o.z = pk2(y[4] * f1, y[5] * f1); o.w = pk2(y[6] * f1, y[7] * f1);
                *(LAS u32x4*)(lds + L_KB + i * 272 + cgp * 16) = o;
                o.x = pk2(y[0] * f2, y[1] * f2); o.y = pk2(y[2] * f2, y[3] * f2); o.z = pk2(y[4] * f2, y[5] * f2); o.w = pk2(y[6] * f2, y[7] * f2);
                *(u32x4*)(kdg + cb * 8192 + i * 128 + cgp * 8) = o;
            } else {
                o.x = pk2(y[0] * bi, y[1] * bi); o.y = pk2(y[2] * bi, y[3] * bi); o.z = pk2(y[4] * bi, y[5] * bi); o.w = pk2(y[6] * bi, y[7] * bi);
                *(LAS u32x4*)(lds + L_VB + i * 272 + cgp * 16) = o;
            }
        }
    }
    __syncthreads();
    const int r = lane & 31, hh = lane >> 5;
    const int i16 = lane & 15, tq = i16 >> 2, tp = i16 & 3, tblk = (lane >> 4) & 1;
    if (next_task >= 0) prep_loads(p, next_task, tid, wid, lane, R);
    for (int idx = tid; idx < 576; idx += 512) *(LAS u32x4*)(lds + L_TM + 16 * idx) = (u32x4){0u, 0u, 0u, 0u};
    {
        const bool isqk = wid >= 4; const int mi = (wid >> 1) & 1, ni = wid & 1;
        const LAS unsigned char* Ap = lds + (isqk ? L_QH : L_KH) + (32 * mi + r) * 272 + 16 * hh; const LAS unsigned char* Bp = lds + L_KH + (32 * ni + r) * 272 + 16 * hh;
        f32x16 acc;
#pragma unroll
        for (int t = 0; t < 16; ++t) acc[t] = 0.f;
#pragma unroll
        for (int ks = 0; ks < 8; ++ks) acc = MFMA32(*(const LAS bf16x8*)(Ap + 32 * ks), *(const LAS bf16x8*)(Bp + 32 * ks), acc);
        const int j = 32 * ni + r; const float Gj = Gs[j];
        const int i0 = 32 * mi + 4 * hh;
        if (!isqk) {
#pragma unroll
            for (int g = 0; g < 4; ++g) { const f32x4 Gi = *(const LAS f32x4*)(Gs + i0 + 8 * g), Bi = *(const LAS f32x4*)(Bs + i0 + 8 * g);
#pragma unroll
                for (int e = 0; e < 4; ++e) { const int i = i0 + 8 * g + e; Nm[i * 68 + j] = (j < i) ? Bi[e] * acc[4 * g + e] * __expf(Gi[e] - Gj) : 0.f; } }
        } else {
            bf16_t* ao = aqkg + cb * 4096 + j;
#pragma unroll
            for (int g = 0; g < 4; ++g) { const f32x4 Gi = *(const LAS f32x4*)(Gs + i0 + 8 * g);
#pragma unroll
                for (int e = 0; e < 4; ++e) { const int i = i0 + 8 * g + e; ao[i * 64] = (bf16_t)f2bf((j <= i) ? acc[4 * g + e] * __expf(Gi[e] - Gj) : 0.f); } }
        }
    }
    __syncthreads();
    if (wid == 0) {
        {
            const int blk = lane >> 4, c = lane & 15;
            float t[16];
            const LAS float* nb = Nm + (16 * blk) * 68 + 16 * blk;
#pragma unroll
            for (int i = 0; i < 16; ++i) {
                float a = (i == c) ? 1.f : 0.f;
#pragma unroll
                for (int j4 = 0; j4 < (i + 3) / 4; ++j4) { const f32x4 nv = *(const LAS f32x4*)(nb + i * 68 + 4 * j4);
#pragma unroll
                    for (int e = 0; e < 4; ++e) if (4 * j4 + e < i) a -= nv[e] * t[4 * j4 + e]; }
                if ((i & 3) == 3) asm volatile("" : "+v"(a) :: "memory");
                t[i] = a;
            }
#pragma unroll
            for (int i = 0; i < 16; ++i) Tm[(16 * blk + i) * 72 + 16 * blk + c] = (bf16_t)f2bf(t[i]);
        }
        {
            const int half = r >> 4, rl = r & 15;
            const LAS float* np = Nm + (16 + 32 * half + rl) * 68 + 32 * half + 8 * hh;
            const f32x4 n0 = *(const LAS f32x4*)np, n1 = *(const LAS f32x4*)(np + 4);
            u32x4 ap; ap.x = pk2(n0[0], n0[1]); ap.y = pk2(n0[2], n0[3]); ap.z = pk2(n1[0], n1[1]); ap.w = pk2(n1[2], n1[3]);
            const LAS unsigned char* tb = lds + L_TM + (32 * tblk + 8 * hh + tq) * 144 + (32 * tblk + 4 * tp) * 2;
            f32x16 X1;
#pragma unroll
            for (int tt = 0; tt < 16; ++tt) X1[tt] = 0.f;
            X1 = MFMA32(__builtin_bit_cast(bf16x8, ap), tr_pair(tb, tb + 4 * 144), X1);
            const u32x4 x0 = __builtin_bit_cast(u32x4, pack8(X1, 0)), x1 = __builtin_bit_cast(u32x4, pack8(X1, 1));
            u32x4 xs; xs.x = half ? x1.x : x0.x; xs.y = half ? x1.y : x0.y; xs.z = half ? x1.z : x0.z; xs.w = half ? x1.w : x0.w;
            const LAS unsigned char* d1 = lds + L_TM + (16 + 32 * half + rl) * 144;
            f32x16 Y;
#pragma unroll
            for (int tt = 0; tt < 16; ++tt) Y[tt] = 0.f;
            Y = MFMA32(ldsfrag_perm(d1, 16 + 32 * half, hh), __builtin_bit_cast(bf16x8, xs), Y);
#pragma unroll
            for (int tt = 0; tt < 16; ++tt) { const int rowl = crow(tt, hh); if ((rowl >> 4) == half) Tm[(16 + 32 * half + (rowl & 15)) * 72 + 32 * half + rl] = (bf16_t)f2bf(-Y[tt]); }
        }
        f32x16 X;
#pragma unroll
        for (int tt = 0; tt < 16; ++tt) X[tt] = 0.f;
#pragma unroll
        for (int s2 = 0; s2 < 2; ++s2) {
            const LAS float* np = Nm + (32 + r) * 68 + 16 * s2 + 8 * hh;
            const f32x4 n0 = *(const LAS f32x4*)np, n1 = *(const LAS f32x4*)(np + 4);
            u32x4 ap; ap.x = pk2(n0[0], n0[1]); ap.y = pk2(n0[2], n0[3]); ap.z = pk2(n1[0], n1[1]); ap.w = pk2(n1[2], n1[3]);
            const LAS unsigned char* tb = lds + L_TM + (16 * s2 + 8 * hh + tq) * 144 + (16 * tblk + 4 * tp) * 2;
            X = MFMA32(__builtin_bit_cast(bf16x8, ap), tr_pair(tb, tb + 4 * 144), X);
        }
        f32x16 R;
#pragma unroll
        for (int tt = 0; tt < 16; ++tt) R[tt] = 0.f;
        const LAS unsigned char* t22 = lds + L_TM + (32 + r) * 144;
        R = MFMA32(ldsfrag_perm(t22, 32, hh), pack8(X, 0), R);
        R = MFMA32(ldsfrag_perm(t22, 48, hh), pack8(X, 1), R);
#pragma unroll
        for (int tt = 0; tt < 16; ++tt) Tm[(32 + crow(tt, hh)) * 72 + r] = (bf16_t)f2bf(-R[tt]);
    }
    __syncthreads();
#pragma unroll
    for (int q = 0; q < 2; ++q) {
        const int id = 2 * wid + q, X = id >> 3, mt = (id & 7) >> 1, nt = id & 1;
        const LAS unsigned char* img = lds + (X ? L_KB : L_VB) + (8 * hh + tq) * 272 + (32 * mt + 16 * tblk + 4 * tp) * 2;
        const LAS unsigned char* Bp = lds + L_TM + (32 * nt + r) * 144 + 16 * hh;
        f32x16 acc;
#pragma unroll
        for (int t = 0; t < 16; ++t) acc[t] = 0.f;
#pragma unroll
        for (int ks = 0; ks < 4; ++ks) { const bf16x8 fa = tr_pair(img + (16 * ks) * 272, img + (16 * ks + 4) * 272), fb = *(const LAS bf16x8*)(Bp + 32 * ks); acc = X ? MFMA32(fa, fb, acc) : MFMA32(fb, fa, acc); }
        bf16_t* dst = X ? Wg + cb * 8192 + (32 * nt + r) * 128 + 32 * mt + 4 * hh : Ug + cb * 8192 + (32 * mt + r) * 64 + 32 * nt + 4 * hh;
#pragma unroll
        for (int g = 0; g < 4; ++g) { u32x2 o; o[0] = pk2(acc[4 * g], acc[4 * g + 1]); o[1] = pk2(acc[4 * g + 2], acc[4 * g + 3]); *(u32x2*)(dst + 8 * g) = o; }
    }
    __syncthreads();
}
DI void fox_prep_task(const Params& p, LAS unsigned char* lds, int task, int tid) {
    const int bh = task / 33, tile = task % 33, b = bh >> 3, h = bh & 7, p0 = 64 * tile;
    const bf16_t* proj = (const bf16_t*)(p.ws + WS_PROJ);
    float* rk = (float*)(p.ws + WS_RK);
    u32x4 kv[2];
#pragma unroll
    for (int it = 0; it < 2; ++it) { const int item = tid + 512 * it, i = item >> 4, cgp = item & 15, pos = p0 + i;
        kv[it] = (u32x4){0u, 0u, 0u, 0u};
        if (pos < LTOT) kv[it] = *(const u32x4*)(proj + (size_t)rowof(b, pos) * NWIDE + COL_FK + h * 128 + cgp * 8); }
#pragma unroll
    for (int it = 0; it < 2; ++it) { const int item = tid + 512 * it, i = item >> 4, cgp = item & 15, pos = p0 + i;
        float ss = 0.f;
#pragma unroll
        for (int e2 = 0; e2 < 4; ++e2) { const float lo = bflo(kv[it][e2]), hi = bfhi(kv[it][e2]); ss += lo * lo + hi * hi; }
        ss = sum16_dpp(ss);
        if (cgp == 0) rk[(size_t)bh * LP + pos] = rsqrtf(ss * (1.f / HD) + EPSF); }
}
DI void cumsum_task(const Params& p, int bh, int lane) {
    const int b = bh >> 3, h = bh & 7; const float* narrow = (const float*)(p.ws + WS_NARROW); float* c2 = (float*)(p.ws + WS_C2);
    const float bias = p.f_bias[h]; float carry = 0.f;
    if (LTOT + lane < LP) ((float*)(p.ws + WS_RK))[(size_t)bh * LP + LTOT + lane] = 1.f;
    float xs[33];
#pragma unroll
    for (int k = 0; k < 33; ++k) { const int pos = 64 * k + lane; xs[k] = pos < LTOT ? narrow[(size_t)rowof(b, pos) * 32 + 16 + h] : 0.f; }
#pragma unroll
    for (int k = 0; k < 33; ++k) {
        const int pos = 64 * k + lane; float lf = 0.f;
        if (pos < LTOT) { const float xx = xs[k] + bias; lf = fminf(xx, 0.f) - __logf(1.f + __expf(-fabsf(xx))); }
        lf = scan64_dpp(lf);
        const float c = carry + lf; c2[(size_t)bh * LP + pos] = c * LOG2E; carry = lane_bcast(c, 63);
    }
}
DI void phase2(const Params& p, LAS unsigned char* lds, int tid, int wid, int lane) {
    constexpr int NG = 64 * NCH;
    const int G = gridDim.x;
    PrepRegs R;
    int t = blockIdx.x;
    if (t < NG) prep_loads(p, t, tid, wid, lane, R);
    if ((int)blockIdx.x >= G - 8) cumsum_task(p, ((int)blockIdx.x - (G - 8)) * 8 + wid, lane);
    for (; t < NG; t += G) {
        asm volatile("" : "+v"(tid)); wid = __builtin_amdgcn_readfirstlane(tid >> 6); lane = tid & 63;
        gdn_prep_task(p, lds, t, t + G < NG ? t + G : -1, tid, wid, lane, R);
    }
}
constexpr int SB_W = 0, SB_Q = 16896, SB_A = 33792, SB_K = 42496, SB_SIZE = 59904, S_OBUF = 2 * SB_SIZE;
DI void gdn_scan_task(const Params& p, LAS unsigned char* lds, int bh, int tid, int wid, int lane) {
    const int b = bh >> 3, h = bh & 7;
    const bf16_t* Ug = (const bf16_t*)(p.ws + WS_U); const bf16_t* Wg = (const bf16_t*)(p.ws + WS_W); const bf16_t* kdg = (const bf16_t*)(p.ws + WS_KDT);
    const bf16_t* qdg = (const bf16_t*)((const unsigned char*)p.out + DO_QD); const bf16_t* aqkg = (const bf16_t*)((const unsigned char*)p.out + DO_AQK);
    const float* decay = (const float*)(p.ws + WS_DECAY);
    const bf16_t* proj = (const bf16_t*)(p.ws + WS_PROJ); bf16_t* merged = (bf16_t*)((unsigned char*)p.out + DO_MERGED);
    LAS bf16_t* obuf16 = (LAS bf16_t*)(lds + S_OBUF);
    LAS float* gws = (LAS float*)(lds + S_OBUF + 34816);
    if (tid < 128) gws[tid] = p.gdn_norm_w[tid];
    const size_t cb0 = (size_t)bh * NCH;
    if (wid < 4) {
        const int sl = wid, r = lane & 31, hh = lane >> 5;
        const int i16 = lane & 15, tq = i16 >> 2, tp = i16 & 3, tblk = (lane >> 4) & 1;
        f32x16 S[4];
#pragma unroll
        for (int kt = 0; kt < 4; ++kt)
#pragma unroll
            for (int t = 0; t < 16; ++t) S[kt][t] = 0.f;
        u32x2 ureg[8]; float dec;
        { const bf16_t* Uc = Ug + cb0 * 8192 + (32 * sl + r) * 64 + 4 * hh;
#pragma unroll
          for (int q8 = 0; q8 < 8; ++q8) ureg[q8] = *(const u32x2*)(Uc + 32 * (q8 >> 2) + 8 * (q8 & 3));
          dec = decay[cb0]; }
        for (int c = 0; c <= NCH; ++c) {
            LDS_BARRIER();
            if (c == NCH) break;
            const LAS unsigned char* sb = lds + (c & 1) * SB_SIZE;
            const LAS unsigned char* rw0 = sb + SB_W + r * 264; const LAS unsigned char* rw1 = rw0 + 32 * 264;
            const LAS unsigned char* rq0 = sb + SB_Q + r * 264; const LAS unsigned char* rq1 = rq0 + 32 * 264;
            const LAS unsigned char* ra0 = sb + SB_A + r * 136; const LAS unsigned char* ra1 = ra0 + 32 * 136;
            const LAS unsigned char* kbase = sb + SB_K + (4 * hh + tq) * 272 + (16 * tblk + 4 * tp) * 2;
            bf16x8 fa[8], fb[8];
#define SBF(ks) pack8(S[(ks) >> 1], (ks) & 1)
#pragma unroll
            for (int k4 = 0; k4 < 4; ++k4) { fa[k4] = ldsfrag_perm(rw0, 16 * k4, hh); fa[4 + k4] = ldsfrag_perm(rw1, 16 * k4, hh); }
            CB();
#pragma unroll
            for (int k4 = 0; k4 < 4; ++k4) { fb[k4] = ldsfrag_perm(rw0, 64 + 16 * k4, hh); fb[4 + k4] = ldsfrag_perm(rw1, 64 + 16 * k4, hh); }
            f32x16 acc0, acc1, o0, o1;
#pragma unroll
            for (int t = 0; t < 16; ++t) { acc0[t] = 0.f; acc1[t] = 0.f; o0[t] = 0.f; o1[t] = 0.f; }
#pragma unroll
            for (int k4 = 0; k4 < 4; ++k4) { acc0 = MFMA32(fa[k4], SBF(k4), acc0); acc1 = MFMA32(fa[4 + k4], SBF(k4), acc1); }
            CB();
#pragma unroll
            for (int k4 = 0; k4 < 4; ++k4) { fa[k4] = ldsfrag_perm(rq0, 16 * k4, hh); fa[4 + k4] = ldsfrag_perm(rq1, 16 * k4, hh); }
#pragma unroll
            for (int k4 = 0; k4 < 4; ++k4) { acc0 = MFMA32(fb[k4], SBF(4 + k4), acc0); acc1 = MFMA32(fb[4 + k4], SBF(4 + k4), acc1); }
            CB();
#pragma unroll
            for (int k4 = 0; k4 < 4; ++k4) { fb[k4] = ldsfrag_perm(rq0, 64 + 16 * k4, hh); fb[4 + k4] = ldsfrag_perm(rq1, 64 + 16 * k4, hh); }
#pragma unroll
            for (int k4 = 0; k4 < 4; ++k4) { o0 = MFMA32(fa[k4], SBF(k4), o0); o1 = MFMA32(fa[4 + k4], SBF(k4), o1); }
            CB();
#pragma unroll
            for (int js = 0; js < 4; ++js) { fa[js] = ldsfrag_perm(ra0, 16 * js, hh); fa[4 + js] = ldsfrag_perm(ra1, 16 * js, hh); }
#pragma unroll
            for (int k4 = 0; k4 < 4; ++k4) { o0 = MFMA32(fb[k4], SBF(4 + k4), o0); o1 = MFMA32(fb[4 + k4], SBF(4 + k4), o1); }
            f32x16 vn0, vn1;
#pragma unroll
            for (int g4 = 0; g4 < 4; ++g4) { const u32x2 u0 = ureg[g4], u1 = ureg[4 + g4];
                vn0[4 * g4] = bflo(u0[0]) - acc0[4 * g4]; vn0[4 * g4 + 1] = bfhi(u0[0]) - acc0[4 * g4 + 1]; vn0[4 * g4 + 2] = bflo(u0[1]) - acc0[4 * g4 + 2]; vn0[4 * g4 + 3] = bfhi(u0[1]) - acc0[4 * g4 + 3];
                vn1[4 * g4] = bflo(u1[0]) - acc1[4 * g4]; vn1[4 * g4 + 1] = bfhi(u1[0]) - acc1[4 * g4 + 1]; vn1[4 * g4 + 2] = bflo(u1[1]) - acc1[4 * g4 + 2]; vn1[4 * g4 + 3] = bfhi(u1[1]) - acc1[4 * g4 + 3]; }
            bf16x8 Vb[4];
            Vb[0] = pack8(vn0, 0); Vb[1] = pack8(vn0, 1); Vb[2] = pack8(vn1, 0); Vb[3] = pack8(vn1, 1);
            CB();
#pragma unroll
            for (int q8 = 0; q8 < 8; ++q8) { const LAS unsigned char* a0 = kbase + (16 * (q8 & 3)) * 272 + 64 * (q8 >> 2); fb[q8] = tr_pair(a0, a0 + 8 * 272); }
#pragma unroll
            for (int js = 0; js < 4; ++js) { o0 = MFMA32(fa[js], Vb[js], o0); o1 = MFMA32(fa[4 + js], Vb[js], o1); }
            CB();
#pragma unroll
            for (int q8 = 0; q8 < 8; ++q8) { const LAS unsigned char* a0 = kbase + (16 * (q8 & 3)) * 272 + 64 * (2 + (q8 >> 2)); fa[q8] = tr_pair(a0, a0 + 8 * 272); }
            { f32x16 a0 = S[0] * dec, a1 = S[1] * dec;
#pragma unroll
              for (int js = 0; js < 4; ++js) { a0 = MFMA32(fb[js], Vb[js], a0); a1 = MFMA32(fb[4 + js], Vb[js], a1); }
              S[0] = a0; S[1] = a1; }
            CB();
            { f32x16 a2 = S[2] * dec, a3 = S[3] * dec;
#pragma unroll
              for (int js = 0; js < 4; ++js) { a2 = MFMA32(fa[js], Vb[js], a2); a3 = MFMA32(fa[4 + js], Vb[js], a3); }
              S[2] = a2; S[3] = a3; }
            if (c + 1 < NCH) {
                const bf16_t* Uc = Ug + (cb0 + c + 1) * 8192 + (32 * sl + r) * 64 + 4 * hh;
#pragma unroll
                for (int q8 = 0; q8 < 8; ++q8) ureg[q8] = *(const u32x2*)(Uc + 32 * (q8 >> 2) + 8 * (q8 & 3));
            }
            if (c + 1 < NCH) dec = decay[cb0 + c + 1];
            if (c > 0) {
                LAS bf16_t* ow = obuf16 + (c & 1) * (64 * 136) + 32 * sl + r;
#pragma unroll
                for (int t = 0; t < 16; ++t) { ow[crow(t, hh) * 136] = (bf16_t)f2bf(o0[t]); ow[(32 + crow(t, hh)) * 136] = (bf16_t)f2bf(o1[t]); }
            }
        }
    } else {
        const int lt = tid & 255, tok = lt >> 2, qtr = lt & 3;
        u32x4 lw[4], lq[4], lk[4], la[2], gz[4];
#define SCAN_LOAD_REGS(cbx) do { \
        _Pragma("unroll") for (int k = 0; k < 4; ++k) { const int id = lt + 256 * k, row = id >> 4, pc = id & 15; \
            lw[k] = *(const u32x4*)(Wg + (cbx) * 8192 + row * 128 + pc * 8); lq[k] = *(const u32x4*)(qdg + (cbx) * 8192 + row * 128 + pc * 8); lk[k] = *(const u32x4*)(kdg + (cbx) * 8192 + row * 128 + pc * 8); } \
        _Pragma("unroll") for (int k = 0; k < 2; ++k) { const int id = lt + 256 * k, row = id >> 3, pc = id & 7; la[k] = *(const u32x4*)(aqkg + (cbx) * 4096 + row * 64 + pc * 8); } \
    } while (0)
#define SCAN_STORE_REGS(sbx) do { \
        _Pragma("unroll") for (int k = 0; k < 4; ++k) { const int id = lt + 256 * k, row = id >> 4, pc = id & 15; \
            LAS u32x2* dw = (LAS u32x2*)((sbx) + SB_W + row * 264 + pc * 16); dw[0] = (u32x2){lw[k].x, lw[k].y}; dw[1] = (u32x2){lw[k].z, lw[k].w}; \
            LAS u32x2* dq = (LAS u32x2*)((sbx) + SB_Q + row * 264 + pc * 16); dq[0] = (u32x2){lq[k].x, lq[k].y}; dq[1] = (u32x2){lq[k].z, lq[k].w}; \
            *(LAS u32x4*)((sbx) + SB_K + row * 272 + pc * 16) = lk[k]; } \
        _Pragma("unroll") for (int k = 0; k < 2; ++k) { const int id = lt + 256 * k, row = id >> 3, pc = id & 7; \
            LAS u32x2* da = (LAS u32x2*)((sbx) + SB_A + row * 136 + pc * 16); da[0] = (u32x2){la[k].x, la[k].y}; da[1] = (u32x2){la[k].z, la[k].w}; } \
    } while (0)
        SCAN_LOAD_REGS(cb0);
        SCAN_STORE_REGS(lds);
        SCAN_LOAD_REGS(cb0 + 1);
#pragma unroll
        for (int e8 = 0; e8 < 4; ++e8) gz[e8] = (u32x4){0u, 0u, 0u, 0u};

        const LAS float* gw = gws + qtr * 32;
        for (int c = 0; c <= NCH; ++c) {
            LDS_BARRIER();
            if (c + 1 < NCH) { LAS unsigned char* sbn = lds + ((c + 1) & 1) * SB_SIZE; SCAN_STORE_REGS(sbn); }
            CB();
            if (c + 2 < NCH) SCAN_LOAD_REGS(cb0 + c + 2);
            CB();
            if (c >= 2) {
                const LAS u32x4* ob = (const LAS u32x4*)(obuf16 + ((c - 1) & 1) * (64 * 136) + tok * 136 + qtr * 32);
                u32x4 ov[4]; float ss = 0.f;
#pragma unroll
                for (int e8 = 0; e8 < 4; ++e8) { ov[e8] = ob[e8];
#pragma unroll
                    for (int e2 = 0; e2 < 4; ++e2) { const float lo = bflo(ov[e8][e2]), hi = bfhi(ov[e8][e2]); ss += lo * lo + hi * hi; } }
                ss = sum4_dpp(ss);
                const float rstd = rsqrtf(ss * (1.f / HD) + EPSF);
                bf16_t* mp = merged + ((size_t)b * SEQ + 64 * (c - 2) + tok) * DM + h * 128 + qtr * 32;
#pragma unroll
                for (int e8 = 0; e8 < 4; ++e8) {
                    const f32x4 v0 = (f32x4){bflo(ov[e8].x), bfhi(ov[e8].x), bflo(ov[e8].y), bfhi(ov[e8].y)}, v1 = (f32x4){bflo(ov[e8].z), bfhi(ov[e8].z), bflo(ov[e8].w), bfhi(ov[e8].w)};
                    const f32x4 w0 = *(const LAS f32x4*)(gw + 8 * e8), w1 = *(const LAS f32x4*)(gw + 8 * e8 + 4);
                    const u32x4 g = gz[e8];
                    u32x4 o;
                    o.x = pk2(v0[0] * rstd * w0[0] * bflo(g.x), v0[1] * rstd * w0[1] * bfhi(g.x));
                    o.y = pk2(v0[2] * rstd * w0[2] * bflo(g.y), v0[3] * rstd * w0[3] * bfhi(g.y));
                    o.z = pk2(v1[0] * rstd * w1[0] * bflo(g.z), v1[1] * rstd * w1[1] * bfhi(g.z));
                    o.w = pk2(v1[2] * rstd * w1[2] * bflo(g.w), v1[3] * rstd * w1[3] * bfhi(g.w));
                    *(u32x4*)(mp + 8 * e8) = o;
                }
            }
            CB();
            if (c >= 1 && c < NCH) {
                const bf16_t* gzp = proj + ((size_t)b * SEQ + 64 * (c - 1) + tok) * NWIDE + COL_GZ + h * 128 + qtr * 32;
#pragma unroll
                for (int e8 = 0; e8 < 4; ++e8) gz[e8] = *(const u32x4*)(gzp + 8 * e8);
            }
        }
#undef SCAN_LOAD_REGS
#undef SCAN_STORE_REGS
    }
    __syncthreads();
}
constexpr int AB_K = 0, AB_V = 17408, AB_C = 34816, AB_R = 35072, AB_SIZE = 35328;
DI void attn_task(const Params& p, LAS unsigned char* lds, int a, int tid, int wid, int lane) {
    const int qblk = 7 - (a >> 6), bh = a & 63, b = bh >> 3, h = bh & 7, r = lane & 31, hh = lane >> 5;
    const bf16_t* proj = (const bf16_t*)(p.ws + WS_PROJ); bf16_t* merged = (bf16_t*)((unsigned char*)p.out + DO_MERGED);
    const int qs = NMETA + 256 * qblk + 32 * wid, qpos = qs + r;
    const size_t row = (size_t)b * SEQ + 256 * qblk + 32 * wid + r;
    const int nT = (271 + 256 * qblk) / 64 + 1;
    const int i16 = lane & 15, tq = i16 >> 2, tp = i16 & 3, tblk = (lane >> 4) & 1;
    u32x4 pk[2], pv[2]; f32x4 pc4 = (f32x4){0.f, 0.f, 0.f, 0.f};
    const float* cbp = (const float*)(p.ws + WS_C2) + (size_t)bh * LP;
    const float* rkp = (const float*)(p.ws + WS_RK) + (size_t)bh * LP;
    float prk[2];
#define ATT_LOAD(j) do { if (tid < 16) pc4 = *(const f32x4*)(cbp + 64 * (j) + 4 * tid); \
        _Pragma("unroll") for (int k = 0; k < 2; ++k) { const int id = tid + 512 * k; int pos = 64 * (j) + (id >> 4); pos = pos < LTOT ? pos : LTOT - 1; \
        const bf16_t* rp = proj + (size_t)rowof(b, pos) * NWIDE + h * 128 + (id & 15) * 8; \
        pk[k] = *(const u32x4*)(rp + COL_FK); pv[k] = *(const u32x4*)(rp + COL_FV); prk[k] = rkp[pos]; } } while (0)
#define ATT_STORE(bufp) do { if (tid < 16) *(LAS f32x4*)((bufp) + AB_C + 16 * tid) = pc4; _Pragma("unroll") for (int k = 0; k < 2; ++k) { const int id = tid + 512 * k; \
        u32x4 kq; const float rs = prk[k];   \
        kq.x = pk2(bflo(pk[k].x) * rs, bfhi(pk[k].x) * rs); kq.y = pk2(bflo(pk[k].y) * rs, bfhi(pk[k].y) * rs); kq.z = pk2(bflo(pk[k].z) * rs, bfhi(pk[k].z) * rs); kq.w = pk2(bflo(pk[k].w) * rs, bfhi(pk[k].w) * rs); \
        *(LAS u32x4*)((bufp) + AB_K + (id >> 4) * 272 + (id & 15) * 16) = kq; *(LAS u32x4*)((bufp) + AB_V + (id >> 4) * 272 + (id & 15) * 16) = pv[k]; } } while (0)
    u32x4 gl[8];
    { const bf16_t* gsrc = proj + ((size_t)b * SEQ + 256 * qblk + (tid >> 1)) * NWIDE + COL_FG + h * 128 + (tid & 1) * 64;
#pragma unroll
      for (int i = 0; i < 8; ++i) gl[i] = *(const u32x4*)(gsrc + 8 * i); }
    ATT_LOAD(nT - 1);
    const bf16_t* qp = proj + row * NWIDE + COL_FQ + h * 128 + 8 * hh;
    u32x4 qraw[8]; float ss = 0.f;
#pragma unroll
    for (int ks = 0; ks < 8; ++ks) qraw[ks] = *(const u32x4*)(qp + 16 * ks);
    CB();
    { LAS unsigned char* gdst = lds + 2 * AB_SIZE + (tid >> 1) * 264 + (tid & 1) * 128;
#pragma unroll
      for (int i = 0; i < 8; ++i) { LAS u32x2* d2 = (LAS u32x2*)(gdst + 16 * i); d2[0] = (u32x2){gl[i].x, gl[i].y}; d2[1] = (u32x2){gl[i].z, gl[i].w}; } }
    CB();
#pragma unroll
    for (int ks = 0; ks < 8; ++ks) {
#pragma unroll
        for (int e = 0; e < 4; ++e) { const float lo = bflo(qraw[ks][e]), hi = bfhi(qraw[ks][e]); ss += lo * lo + hi * hi; } }
    ss = xhalf_sum(ss);
    const float qsc = rsqrtf(ss * (1.f / HD) + EPSF);
    const LAS float* qw = (const LAS float*)(lds + L_QW);
    bf16x8 Qb[8];
#pragma unroll
    for (int ks = 0; ks < 8; ++ks) { const f32x4 w0 = *(const LAS f32x4*)(qw + 16 * ks + 8 * hh), w1 = *(const LAS f32x4*)(qw + 16 * ks + 8 * hh + 4);
        u32x4 o; o.x = pk2(bflo(qraw[ks].x) * qsc * w0[0], bfhi(qraw[ks].x) * qsc * w0[1]); o.y = pk2(bflo(qraw[ks].y) * qsc * w0[2], bfhi(qraw[ks].y) * qsc * w0[3]);
        o.z = pk2(bflo(qraw[ks].z) * qsc * w1[0], bfhi(qraw[ks].z) * qsc * w1[1]); o.w = pk2(bflo(qraw[ks].w) * qsc * w1[2], bfhi(qraw[ks].w) * qsc * w1[3]);
        Qb[ks] = __builtin_bit_cast(bf16x8, o); }
    f32x16 O[4];
#pragma unroll
    for (int dt = 0; dt < 4; ++dt)
#pragma unroll
        for (int t = 0; t < 16; ++t) O[dt][t] = 0.f;
    float m = -INFINITY, l = 0.f;
    ATT_STORE(lds);
    __syncthreads();
    for (int it = 0; it < nT; ++it) {
        const int j = nT - 1 - it;
        const LAS unsigned char* buf = lds + (it & 1) * AB_SIZE;
        if (it + 1 < nT) ATT_LOAD(j - 1);
#pragma unroll
        for (int stt = 0; stt < 2; ++stt) {
            const int st = 1 - stt;
            const int kb = 64 * j + 32 * st;
            if (kb <= qs + 31) {
                f32x16 s;
#pragma unroll
                for (int t = 0; t < 16; ++t) s[t] = 0.f;
                const LAS unsigned char* kp = buf + AB_K + (32 * st + r) * 272 + 16 * hh;
                bf16x8 kf[4], vf[4];
#pragma unroll
                for (int ks = 0; ks < 4; ++ks) kf[ks] = *(const LAS bf16x8*)(kp + 32 * ks);
                CB();
                f32x16 s2;
#pragma unroll
                for (int t = 0; t < 16; ++t) s2[t] = 0.f;
#pragma unroll
                for (int ks = 0; ks < 4; ks += 2) { s = MFMA32(kf[ks], Qb[ks], s); s2 = MFMA32(kf[ks + 1], Qb[ks + 1], s2); }
#pragma unroll
                for (int ks = 0; ks < 4; ++ks) kf[ks] = *(const LAS bf16x8*)(kp + 128 + 32 * ks);
                CB();
#pragma unroll
                for (int ks = 0; ks < 4; ks += 2) { s = MFMA32(kf[ks], Qb[4 + ks], s); s2 = MFMA32(kf[ks + 1], Qb[4 + ks + 1], s2); }
                s = s + s2;
                const LAS unsigned char* vp0 = buf + AB_V + (32 * st + 4 * hh + tq) * 272 + (16 * tblk + 4 * tp) * 2;
#pragma unroll
                for (int dt = 0; dt < 2; ++dt) { const LAS unsigned char* vp = vp0 + 64 * dt; vf[2 * dt] = tr_pair(vp, vp + 8 * 272); vf[2 * dt + 1] = tr_pair(vp + 16 * 272, vp + 24 * 272); }
                CB();
                const bool needmask = (kb + 31 > qs);
                float mx = -INFINITY;
#pragma unroll
                for (int g = 0; g < 4; ++g) { const f32x4 nb4 = -*(const LAS f32x4*)(buf + AB_C + 4 * (32 * st + 8 * g + 4 * hh));
                    if (needmask) {
#pragma unroll
                        for (int e = 0; e < 4; ++e) { float v = s[4 * g + e] + nb4[e]; if (kb + 8 * g + 4 * hh + e > qpos) v = -INFINITY; s[4 * g + e] = v; mx = fmaxf(mx, v); }
                    } else {
#pragma unroll
                        for (int e = 0; e < 4; ++e) { const float v = s[4 * g + e] + nb4[e]; s[4 * g + e] = v; mx = fmaxf(mx, v); }
                    } }
                mx = xhalf_max(mx);
                const float mn = fmaxf(m, mx);
                const float mref = (mn == -INFINITY) ? 0.f : mn;
                const float alpha = __builtin_amdgcn_exp2f(m - mref);
                float ps = 0.f;
#pragma unroll
                for (int t = 0; t < 16; ++t) { const float pv_ = __builtin_amdgcn_exp2f(s[t] - mref); s[t] = pv_; ps += pv_; }
                m = mn;
                if (__builtin_amdgcn_ballot_w64(alpha != 1.f) != 0ull) {
                    l = l * alpha + ps;
#pragma unroll
                    for (int dt = 0; dt < 4; ++dt) O[dt] = O[dt] * alpha;
                } else l += ps;
                const bf16x8 P0 = pack8(s, 0), P1 = pack8(s, 1);
                bf16x8 vg[4];
#pragma unroll
                for (int dt = 0; dt < 2; ++dt) { const LAS unsigned char* vp = vp0 + 64 * (2 + dt); vg[2 * dt] = tr_pair(vp, vp + 8 * 272); vg[2 * dt + 1] = tr_pair(vp + 16 * 272, vp + 24 * 272); }
#pragma unroll
                for (int dt = 0; dt < 2; ++dt) { O[dt] = MFMA32(vf[2 * dt], P0, O[dt]); O[dt] = MFMA32(vf[2 * dt + 1], P1, O[dt]); }
                CB();
#pragma unroll
                for (int dt = 0; dt < 2; ++dt) { O[2 + dt] = MFMA32(vg[2 * dt], P0, O[2 + dt]); O[2 + dt] = MFMA32(vg[2 * dt + 1], P1, O[2 + dt]); }
            }
        }
        if (it + 1 < nT) { LAS unsigned char* nb = lds + ((it + 1) & 1) * AB_SIZE; ATT_STORE(nb); }
        __syncthreads();
    }
#undef ATT_LOAD
#undef ATT_STORE
    l = xhalf_sum(l);
    const float inv = 1.f / l;
    bf16_t* mp = merged + row * DM + 1024 + h * 128 + 4 * hh;
    const LAS unsigned char* gp = lds + 2 * AB_SIZE + (32 * wid + r) * 264 + 8 * hh;
    u32x2 gzs[16];
#pragma unroll
    for (int i = 0; i < 16; ++i) gzs[i] = *(const LAS u32x2*)(gp + 64 * (i >> 2) + 16 * (i & 3));
#pragma unroll
    for (int dt = 0; dt < 4; ++dt)
#pragma unroll
        for (int g = 0; g < 4; ++g) { const u32x2 gz = gzs[4 * dt + g];
            u32x2 o; o[0] = pk2(O[dt][4 * g] * inv * bflo(gz[0]), O[dt][4 * g + 1] * inv * bfhi(gz[0]));
            o[1] = pk2(O[dt][4 * g + 2] * inv * bflo(gz[1]), O[dt][4 * g + 3] * inv * bfhi(gz[1]));
            *(u32x2*)(mp + 32 * dt + 8 * g) = o; }
}
DI void phase3(const Params& p, LAS unsigned char* lds, int tid, int wid, int lane, int rep) {
    LAS int* stask = (LAS int*)(lds + LDS_BYTES - 16);
    unsigned* ctr = (unsigned*)(p.ws + WS_CTR) + rep;
    if (tid < 128) ((LAS float*)(lds + L_QW))[tid] = p.fq_w[tid] * p.fk_w[tid] * (0.08838834764831845f * LOG2E);
    if (tid == 0) stask[0] = (int)atomicAdd(ctr, 1u);
    __syncthreads();
    int t = stask[0];
    __syncthreads();
    while (t < 64 + 512) {
        asm volatile("" : "+v"(tid)); wid = __builtin_amdgcn_readfirstlane(tid >> 6); lane = tid & 63;
        if (t < 64) gdn_scan_task(p, lds, t, tid, wid, lane);
        else attn_task(p, lds, t - 64, tid, wid, lane);
        if (tid == 0) stask[0] = (int)atomicAdd(ctr, 1u);
        __syncthreads();
        t = stask[0];
        __syncthreads();
    }
}
DI void phase5(const Params& p, int gw, int ngw, int lane) {
    const bf16_t* ob = (const bf16_t*)(p.ws + WS_OUT);
    f32x4 w[8];
#pragma unroll
    for (int j = 0; j < 8; ++j) w[j] = ((const f32x4*)p.post_w)[lane + 64 * j];
    for (int row = gw; row < MR; row += ngw) {
        const u32x2* src = (const u32x2*)(ob + (size_t)row * DM); const f32x4* xs = (const f32x4*)(p.x + (size_t)row * DM);
        u32x2 vb[8]; f32x4 xv[8]; float ss = 0.f;
#pragma unroll
        for (int j = 0; j < 8; ++j) { vb[j] = __builtin_nontemporal_load(src + lane + 64 * j); xv[j] = __builtin_nontemporal_load(xs + lane + 64 * j); }
        CB();
        f32x4 v[8];
#pragma unroll
        for (int j = 0; j < 8; ++j) { v[j] = (f32x4){bflo(vb[j][0]), bfhi(vb[j][0]), bflo(vb[j][1]), bfhi(vb[j][1])}; ss += v[j][0] * v[j][0] + v[j][1] * v[j][1] + v[j][2] * v[j][2] + v[j][3] * v[j][3]; }
        ss = wave_sum(ss);
        const float rstd = rsqrtf(ss * (1.f / DM) + EPSF);
#pragma unroll
        for (int j = 0; j < 8; ++j) __builtin_nontemporal_store(xv[j] + v[j] * rstd * w[j], (f32x4*)(p.out + (size_t)row * DM) + lane + 64 * j);
    }
}

#define XB_TMO      128
#define XB_XCNT(j)  (256  + 64 * (j))
#define XB_XSUB(j)  (1280 + 64 * (j))
#define XB_XGEN(j)  (2304 + 64 * (j))
#define XB_TOP      3328
#define XB_TOPGEN   3392
#define XCD_BAR_WORDS 3456
#define XB_SPIN_CAP (1u << 18)

__device__ __forceinline__ unsigned xb_ld(unsigned* p)              { return __hip_atomic_load(p, __ATOMIC_RELAXED, __HIP_MEMORY_SCOPE_AGENT); }
__device__ __forceinline__ unsigned xb_add(unsigned* p, unsigned v) { return __hip_atomic_fetch_add(p, v, __ATOMIC_RELAXED, __HIP_MEMORY_SCOPE_AGENT); }
__device__ __forceinline__ unsigned xb_xcc_id() { return (unsigned)__builtin_amdgcn_s_getreg((3 << 11) | 20) & 0xFu; }
#define XB_SPIN(cond, bar) do { unsigned _sp = 0; while (cond) { __builtin_amdgcn_s_sleep(1); \
    if ((++_sp & 255u) == 0u) { if (xb_ld(&(bar)[XB_TMO])) break; if (_sp > XB_SPIN_CAP) { atomicAdd(&(bar)[XB_TMO], 1u); break; } } } } while (0)

struct XcdBarrier {
    unsigned* bar; unsigned x;
    volatile LAS unsigned* st;
};

__device__ __forceinline__ XcdBarrier xcd_barrier_post(unsigned* bar, volatile LAS unsigned* st) {
    XcdBarrier b; b.bar = bar; b.x = xb_xcc_id(); b.st = st;
    if (threadIdx.x == 0) (void)xb_add(&bar[XB_XCNT(b.x)], 1u);
    return b;
}
__device__ __forceinline__ void xcd_barrier_complete(unsigned* bar, unsigned x, unsigned& nloc, unsigned& nx) {
    const unsigned G = gridDim.x * gridDim.y * gridDim.z;
    unsigned sum, cnt, mine, sp = 0u;
    for (;;) {
        sum = 0u; cnt = 0u; mine = 0u;
#pragma unroll
        for (unsigned j = 0; j < 16; ++j) { const unsigned c = xb_ld(&bar[XB_XCNT(j)]); sum += c; cnt += (c > 0u) ? 1u : 0u; mine = (j == x) ? c : mine; }
        if (sum == G) break;
        __builtin_amdgcn_s_sleep(1);
        if ((++sp & 255u) == 0u) { if (xb_ld(&bar[XB_TMO])) break; if (sp > XB_SPIN_CAP) { atomicAdd(&bar[XB_TMO], 1u); break; } }
    }
    nloc = mine > 0u ? mine : 1u; nx = cnt > 0u ? cnt : 1u;
}

__device__ __forceinline__ void xcd_barrier(const XcdBarrier& b) {
    asm volatile("s_waitcnt vmcnt(0)" ::: "memory");
    __syncthreads();
    if (threadIdx.x == 0) {
        unsigned* bar = b.bar;
        __builtin_amdgcn_s_waitcnt(0);
        unsigned nloc = b.st[0], nx = b.st[1];
        if (nloc == 0u) { xcd_barrier_complete(bar, b.x, nloc, nx); b.st[0] = nloc; b.st[1] = nx; }
        const unsigned old = xb_add(&bar[XB_XSUB(b.x)], 1u);
        const unsigned gen = old / nloc;
        if (old + 1u == (gen + 1u) * nloc) {
            __builtin_amdgcn_fence(__ATOMIC_RELEASE, "agent");
            asm volatile("s_waitcnt vmcnt(0)" ::: "memory");
            const unsigned og = xb_add(&bar[XB_TOP], 1u);
            const unsigned tg = og / nx;
            if (og + 1u == (tg + 1u) * nx) xb_add(&bar[XB_TOPGEN], 1u);
            else XB_SPIN(xb_ld(&bar[XB_TOPGEN]) == tg, bar);
            __builtin_amdgcn_fence(__ATOMIC_ACQUIRE, "agent");
            xb_add(&bar[XB_XGEN(b.x)], 1u);
            asm volatile("s_waitcnt vmcnt(0)" ::: "memory");
        } else {
            XB_SPIN(xb_ld(&bar[XB_XGEN(b.x)]) == gen, bar);
            __builtin_amdgcn_fence(__ATOMIC_ACQUIRE, "agent");
            asm volatile("s_waitcnt vmcnt(0)" ::: "memory");
        }
    }
    __syncthreads();
}


DI void grid_barrier(unsigned* ctr, unsigned target) {
    asm volatile("s_waitcnt vmcnt(0) lgkmcnt(0)" ::: "memory");
    __syncthreads();
    if (threadIdx.x == 0) {
        __builtin_amdgcn_fence(__ATOMIC_RELEASE, "agent");
        asm volatile("s_waitcnt vmcnt(0)" ::: "memory");
        __hip_atomic_fetch_add(ctr, 1u, __ATOMIC_RELAXED, __HIP_MEMORY_SCOPE_AGENT);
        while (__hip_atomic_load(ctr, __ATOMIC_RELAXED, __HIP_MEMORY_SCOPE_AGENT) < target) __builtin_amdgcn_s_sleep(2);
        __builtin_amdgcn_fence(__ATOMIC_ACQUIRE, "agent");
        asm volatile("s_waitcnt vmcnt(0)" ::: "memory");
    }
    __syncthreads();
}
__global__ void __launch_bounds__(512, 2) hymba_fwd(Params p) {
    extern __shared__ __attribute__((aligned(16))) unsigned char smem[];
    LAS unsigned char* lds = (LAS unsigned char*)smem;
    cg::grid_group grid = cg::this_grid();
    unsigned* gbar = (unsigned*)(p.ws + WS_BAR);
    volatile LAS unsigned* xst = (volatile LAS unsigned*)(lds + LDS_BYTES - 32);
    if (threadIdx.x == 0) { xst[0] = 0u; xst[1] = 0u; }
    __syncthreads();
    const XcdBarrier xbar = xcd_barrier_post(gbar, xst);
    if (p.ws == nullptr) grid.sync();
    int tid = threadIdx.x, wid, lane;
    const int wid0 = __builtin_amdgcn_readfirstlane((int)threadIdx.x >> 6);
#define RELOAD_IDS() do { tid = threadIdx.x; asm volatile("" : "+v"(tid)); wid = __builtin_amdgcn_readfirstlane(tid >> 6); lane = tid & 63; } while (0)
#define RELOAD_IDS2() do { lane = __builtin_amdgcn_mbcnt_hi(~0u, __builtin_amdgcn_mbcnt_lo(~0u, 0u)); wid = wid0; tid = wid0 * 64 + lane; asm volatile("" : "+v"(tid)); } while (0)
    RELOAD_IDS();
    phase0(p, lds, tid, wid, lane);
    xcd_barrier(xbar);
    for (int rep = 0; rep < REP1; ++rep) { if (rep) grid.sync();
    { pg8::Gemm g; g.A = (const bf16_t*)(p.ws + WS_XN); g.Bt = (const bf16_t*)(p.ws + WS_WINT); g.M = MPAD; g.N = NPAD; g.K = DM;
      pg8::StaticOrder S; S.init(MPAD, NPAD, gridDim.x, blockIdx.x);
      EpiProj E; E.P = (bf16_t*)(p.ws + WS_PROJ); E.narrow = (float*)(p.ws + WS_NARROW);
      pg8::gemm_phase<EpiProj, pg8::StaticOrder, true, true>(lds, g, S, E, tid); } }
    xcd_barrier(xbar);
    for (int rep = 0; rep < REP2; ++rep) { if (rep) grid.sync();
    RELOAD_IDS();
    phase2(p, lds, tid, wid, lane); }
    xcd_barrier(xbar);
    for (int rep = 0; rep < REP3; ++rep) { if (rep) grid.sync();
    RELOAD_IDS();
    phase3(p, lds, tid, wid, lane, rep); }
    xcd_barrier(xbar);
    { pg8::Gemm g; g.A = (const bf16_t*)((const unsigned char*)p.out + DO_MERGED); g.Bt = (const bf16_t*)(p.ws + WS_WOUTT); g.M = MR; g.N = DM; g.K = DM;
      pg8::StaticOrder S; S.init(MR, DM, gridDim.x, blockIdx.x);
      EpiOut E; E.C = (bf16_t*)(p.ws + WS_OUT);
      RELOAD_IDS2();
      pg8::gemm_phase<EpiOut, pg8::StaticOrder, true, true>(lds, g, S, E, tid); }
    xcd_barrier(xbar);
    RELOAD_IDS2();
    phase5(p, blockIdx.x * 8 + wid, gridDim.x * 8, lane);
}

extern "C" void kernel_launch(void* const* d_in, const int* in_sizes, int n_in, void* d_out, int out_size, void* d_ws, size_t ws_size, hipStream_t stream) {
    static int grid_blocks = 0;
    if (!grid_blocks) {
        int dev = 0, cus = 0, per_cu = 0;
        hipGetDevice(&dev);
        hipDeviceGetAttribute(&cus, hipDeviceAttributeMultiprocessorCount, dev);
        hipFuncSetAttribute((const void*)hymba_fwd, hipFuncAttributeMaxDynamicSharedMemorySize, LDS_BYTES);
        hipOccupancyMaxActiveBlocksPerMultiprocessor(&per_cu, (const void*)hymba_fwd, 512, LDS_BYTES);
        if (per_cu < 1) per_cu = 1;
        grid_blocks = cus;
        if (ws_size < WS_END) fprintf(stderr, "kernel_launch: workspace too small: %zu < %zu\n", ws_size, (size_t)WS_END);
    }
    Params p{};
    p.x = (const float*)d_in[0]; p.meta = (const float*)d_in[1]; p.pre_w = (const float*)d_in[2]; p.w_in = (const float*)d_in[3]; p.conv_w = (const float*)d_in[4];
    p.a_log = (const float*)d_in[5]; p.dt_bias = (const float*)d_in[6]; p.gdn_norm_w = (const float*)d_in[7]; p.fq_w = (const float*)d_in[8]; p.fk_w = (const float*)d_in[9];
    p.f_bias = (const float*)d_in[10]; p.w_out = (const float*)d_in[11]; p.post_w = (const float*)d_in[12];
    p.out = (float*)d_out; p.ws = (unsigned char*)d_ws;
    (void)hipMemsetAsync((unsigned char*)d_ws + WS_BAR, 0, 16384, stream);
    void* args[] = {&p};
    hipError_t e = hipLaunchCooperativeKernel((const void*)hymba_fwd, dim3(grid_blocks), dim3(512), args, LDS_BYTES, stream);
    if (e != hipSuccess) fprintf(stderr, "cooperative launch failed: %s (grid %d)\n", hipGetErrorString(e), grid_blocks);
}
```

```cpp
#include <hip/hip_runtime.h>
#include <hip/hip_cooperative_groups.h>
#include <cstdio>
namespace cg = cooperative_groups;

#define DI __device__ __forceinline__
#define LAS __attribute__((address_space(3)))
typedef float f32x16 __attribute__((ext_vector_type(16)));
typedef short s16x4 __attribute__((ext_vector_type(4)));
typedef unsigned u32x2 __attribute__((ext_vector_type(2)));

namespace pg8 {
#define PG8_LAS __attribute__((address_space(3)))
typedef unsigned short bf16_t;
typedef short bf16x8 __attribute__((ext_vector_type(8)));
typedef float f32x4 __attribute__((ext_vector_type(4)));
typedef unsigned u32x4 __attribute__((ext_vector_type(4)));
constexpr int BM = 256, BK = 64, HALF = 128, HTB = HALF * BK * 2  , STAGE_BYTES = 8 * HTB, NXCD = 8, WGM = 8;

__host__ __device__ __forceinline__ int lds_byte(int r, int c) { const int st = (r >> 4) * 2 + (c >> 5), rr = r & 15, cc = c & 31, ob = rr * 64 + cc * 2; return st * 1024 + (ob ^ (((ob >> 9) & 1) << 5)); }
__host__ __device__ __forceinline__ void stage_rc(int b, int& R, int& C) { const int st = b / 1024, sb = b % 1024, swz = sb ^ (((sb >> 9) & 1) << 5); R = (st >> 1) * 16 + swz / 64; C = (st & 1) * 32 + (swz % 64) / 2; }
__host__ __device__ __forceinline__ int perm32(int rho) { const int n = rho >> 4, i = rho & 15; return 8 * (i >> 2) + 4 * n + (i & 3); }

struct Unit { int pm, pn; };
struct Gemm { const bf16_t* A; const bf16_t* Bt; int M, N, K; };

struct StaticOrder {
    int nM, nN, nwg, G, c;
    __host__ __device__ void init(int M, int N, int G_, int c_) { nM = M / BM; nN = N / BM; nwg = nM * nN; G = G_; c = c_; }
    __host__ __device__ bool next(int i, Unit& u) const {
        const long L = (long)i * G + c; if (L >= nwg) return false;
        int wgid = (int)L; { const int q = nwg / NXCD, r = nwg % NXCD, xcd = wgid % NXCD, off = wgid / NXCD; wgid = (xcd < r ? xcd * (q + 1) : r * (q + 1) + (xcd - r) * q) + off; }
        const int nig = WGM * nN, gid = wgid / nig, fm = gid * WGM, gsz = (nM - fm) < WGM ? (nM - fm) : WGM;
        u.pm = fm + ((wgid % nig) % gsz); u.pn = (wgid % nig) / gsz; return true;
    }
    __device__ __forceinline__ void a_ready(const Unit&) const {}
    __device__ __forceinline__ void done(const Unit&) const {}
};
typedef unsigned u32x4 __attribute__((ext_vector_type(4)));
template <class Epi, class Sched, bool ALIGN_EPI = false, bool SP2 = false>
__device__ __forceinline__ void gemm_phase(PG8_LAS unsigned char* lds, const Gemm g, const Sched& S, const Epi& E, const int tid) {
    const int wid = __builtin_amdgcn_readfirstlane(tid >> 6), lane = tid & 63, wr = wid >> 2, wc = wid & 3, fr = lane & 15, fq = lane >> 4;
    const int K = g.K, nt = K / BK;
    unsigned voffA[2], voffB[2];
#pragma unroll
    for (int i = 0; i < 2; ++i) { int R, C; stage_rc(tid * 16 + i * 8192, R, C); const int Rb = Epi::PERM ? ((R & ~31) + perm32(R & 31)) : R;
        voffA[i] = (unsigned)(R * K + C) * 2u; voffB[i] = (unsigned)(Rb * K + C) * 2u; }
    const size_t kstep = (size_t)(BK * 2);
    const size_t hstep = (size_t)HALF * K * 2;
    const size_t tstep = 2 * hstep;
    const unsigned ldsw = (unsigned)wid * 1024u;
    const int aoff = lds_byte(wr * 64 + fr, fq * 8), boff = lds_byte(wc * 32 + fr, fq * 8);
#define PG8_SA(b, h) (((b) * 2 + (h)) * HTB)
#define PG8_SB(b, h) ((4 + (b) * 2 + (h)) * HTB)
#define PG8_STAGE(bufoff, gbase, voff) do { _Pragma("unroll") for (int _i = 0; _i < 2; ++_i) \
        __builtin_amdgcn_global_load_lds((const unsigned*)((const char*)(gbase) + (voff)[_i]), (PG8_LAS unsigned*)(lds + (bufoff) + ldsw + _i * 8192), 16, 0, 0); } while (0)
#define PG8_LDA(dst, b, h) do { _Pragma("unroll") for (int m = 0; m < 4; ++m) _Pragma("unroll") for (int k = 0; k < 2; ++k) dst[m][k] = *(const PG8_LAS bf16x8*)(lds + PG8_SA(b, h) + aoff + m * 2048 + k * 1024); } while (0)
#define PG8_LDB(dst, b, h) do { _Pragma("unroll") for (int n = 0; n < 2; ++n) _Pragma("unroll") for (int k = 0; k < 2; ++k) dst[n][k] = *(const PG8_LAS bf16x8*)(lds + PG8_SB(b, h) + boff + n * 2048 + k * 1024); } while (0)
#define PG8_MMA(ai, bj, At, Bt) do { __builtin_amdgcn_s_setprio(1); _Pragma("unroll") for (int m = 0; m < 4; ++m) _Pragma("unroll") for (int n = 0; n < 2; ++n) _Pragma("unroll") for (int k = 0; k < 2; ++k) \
        acc[ai][bj][m][n] = __builtin_amdgcn_mfma_f32_16x16x32_bf16(Bt[n][k], At[m][k], acc[ai][bj][m][n], 0, 0, 0); __builtin_amdgcn_s_setprio(0); } while (0)
#define PG8_WAIT_V(n) asm volatile("s_waitcnt vmcnt(" #n ")" ::: "memory")
#define PG8_WAIT_L(n) asm volatile("s_waitcnt lgkmcnt(" #n ")" ::: "memory")
#define PG8_BAR __builtin_amdgcn_s_barrier()
#define PG8_SCHED __builtin_amdgcn_sched_barrier(0)
    Unit cur, nxt; int ui = 0;
    if (!S.next(0, cur)) return;
    f32x4 acc[2][2][4][2];
#pragma unroll
    for (int a = 0; a < 2; ++a)
#pragma unroll
        for (int b = 0; b < 2; ++b)
#pragma unroll
            for (int m = 0; m < 4; ++m)
#pragma unroll
                for (int n = 0; n < 2; ++n) acc[a][b][m][n] = (f32x4){0.f, 0.f, 0.f, 0.f};
    bf16x8 At[4][2], B0[2][2], B1[2][2];
    const char* cA = (const char*)g.A + (size_t)cur.pm * tstep; const char* cB = (const char*)g.Bt + (size_t)cur.pn * tstep;
    S.a_ready(cur);
    if constexpr (SP2) {
        PG8_STAGE(PG8_SB(0, 0), cB, voffB); PG8_STAGE(PG8_SB(0, 1), cB + hstep, voffB); PG8_STAGE(PG8_SA(0, 0), cA, voffA); PG8_STAGE(PG8_SA(0, 1), cA + hstep, voffA);
        if (wr == 1) PG8_BAR;
        PG8_WAIT_V(2); PG8_BAR;
        PG8_STAGE(PG8_SB(1, 0), cB + kstep, voffB); PG8_STAGE(PG8_SA(1, 0), cA + kstep, voffA); PG8_STAGE(PG8_SB(1, 1), cB + hstep + kstep, voffB);
        PG8_WAIT_V(6); PG8_BAR;
    } else {
        PG8_STAGE(PG8_SB(0, 0), cB, voffB); PG8_STAGE(PG8_SA(0, 0), cA, voffA); PG8_STAGE(PG8_SB(0, 1), cB + hstep, voffB); PG8_STAGE(PG8_SA(0, 1), cA + hstep, voffA);
        if (wr == 1) PG8_BAR;
        PG8_WAIT_V(4); PG8_BAR;
        PG8_STAGE(PG8_SB(1, 0), cB + kstep, voffB); PG8_STAGE(PG8_SA(1, 0), cA + kstep, voffA); PG8_STAGE(PG8_SB(1, 1), cB + hstep + kstep, voffB);
        PG8_WAIT_V(6); PG8_BAR;
    }
    for (;;) {
        const bool has_next = S.next(ui + 1, nxt);
        const char* nA = has_next ? (const char*)g.A + (size_t)nxt.pm * tstep : cA; const char* nB = has_next ? (const char*)g.Bt + (size_t)nxt.pn * tstep : cB;
        for (int t = 0; t < nt; t += 2) {
            const bool last = (t == nt - 2);
            const char* a1 = cA + (size_t)(t + 1) * kstep;
            const char* a2 = last ? nA : cA + (size_t)(t + 2) * kstep; const char* b2 = last ? nB : cB + (size_t)(t + 2) * kstep;
            const char* a3 = a2 + kstep; const char* b3 = b2 + kstep;
            if (last && has_next) S.a_ready(nxt);
            if constexpr (SP2) {
            PG8_LDB(B0, 0, 0); PG8_LDB(B1, 0, 1); PG8_SCHED; PG8_LDA(At, 0, 0); PG8_STAGE(PG8_SA(1, 1), a1 + hstep, voffA);
            PG8_WAIT_V(8); PG8_WAIT_L(0); PG8_BAR; PG8_MMA(0, 0, At, B0); PG8_MMA(0, 1, At, B1); PG8_BAR; PG8_SCHED;
            PG8_LDA(At, 0, 1); PG8_STAGE(PG8_SB(0, 0), b2, voffB); PG8_STAGE(PG8_SB(0, 1), b2 + hstep, voffB); PG8_STAGE(PG8_SA(0, 0), a2, voffA);
            PG8_WAIT_V(8); PG8_WAIT_L(0); PG8_BAR; PG8_MMA(1, 0, At, B0); PG8_MMA(1, 1, At, B1); PG8_BAR; PG8_SCHED;
            PG8_LDB(B0, 1, 0); PG8_LDB(B1, 1, 1); PG8_SCHED; PG8_LDA(At, 1, 0); PG8_STAGE(PG8_SA(0, 1), a2 + hstep, voffA);
            PG8_WAIT_V(8); PG8_WAIT_L(0); PG8_BAR; PG8_MMA(0, 0, At, B0); PG8_MMA(0, 1, At, B1); PG8_BAR; PG8_SCHED;
            PG8_LDA(At, 1, 1); PG8_STAGE(PG8_SB(1, 0), b3, voffB); PG8_STAGE(PG8_SB(1, 1), b3 + hstep, voffB); PG8_STAGE(PG8_SA(1, 0), a3, voffA);
            PG8_WAIT_V(8); PG8_WAIT_L(0); PG8_BAR; PG8_MMA(1, 0, At, B0); PG8_MMA(1, 1, At, B1); PG8_BAR; PG8_SCHED;
            } else {
            PG8_LDB(B0, 0, 0); PG8_SCHED; PG8_LDA(At, 0, 0); PG8_STAGE(PG8_SA(1, 1), a1 + hstep, voffA);
            PG8_WAIT_L(8); PG8_BAR; PG8_WAIT_L(0); PG8_MMA(0, 0, At, B0); PG8_BAR; PG8_SCHED;
            PG8_LDB(B1, 0, 1); PG8_STAGE(PG8_SB(0, 0), b2, voffB);
            PG8_BAR; PG8_WAIT_L(0); PG8_MMA(0, 1, At, B1); PG8_BAR;
            PG8_LDA(At, 0, 1); PG8_STAGE(PG8_SA(0, 0), a2, voffA);
            PG8_BAR; PG8_WAIT_L(0); PG8_MMA(1, 0, At, B0); PG8_BAR; PG8_SCHED;
            PG8_STAGE(PG8_SB(0, 1), b2 + hstep, voffB);
            PG8_WAIT_V(6); PG8_BAR; PG8_MMA(1, 1, At, B1); PG8_BAR;
            PG8_LDB(B0, 1, 0); PG8_SCHED; PG8_LDA(At, 1, 0); PG8_STAGE(PG8_SA(0, 1), a2 + hstep, voffA);
            PG8_WAIT_L(8); PG8_BAR; PG8_WAIT_L(0); PG8_MMA(0, 0, At, B0); PG8_BAR; PG8_SCHED;
            PG8_LDB(B1, 1, 1); PG8_STAGE(PG8_SB(1, 0), b3, voffB);
            PG8_BAR; PG8_WAIT_L(0); PG8_MMA(0, 1, At, B1); PG8_BAR;
            PG8_LDA(At, 1, 1); PG8_STAGE(PG8_SA(1, 0), a3, voffA);
            PG8_BAR; PG8_WAIT_L(0); PG8_MMA(1, 0, At, B0); PG8_BAR; PG8_SCHED;
            PG8_STAGE(PG8_SB(1, 1), b3 + hstep, voffB);
            PG8_WAIT_V(6); PG8_BAR; PG8_MMA(1, 1, At, B1); PG8_BAR;
            }
        }
        if constexpr (ALIGN_EPI) { if (wr == 0) PG8_BAR; }
        if constexpr (!Epi::AFTER_DRAIN) { E(acc, cur, wr, wc, fr, fq); S.done(cur); }
        if (!has_next) break;
#pragma unroll
        for (int a = 0; a < 2; ++a)
#pragma unroll
            for (int b = 0; b < 2; ++b)
#pragma unroll
                for (int m = 0; m < 4; ++m)
#pragma unroll
                    for (int n = 0; n < 2; ++n) acc[a][b][m][n] = (f32x4){0.f, 0.f, 0.f, 0.f};
        cur = nxt; cA = nA; cB = nB; ++ui;
        if constexpr (ALIGN_EPI) { if (wr == 1) PG8_BAR; }
    }
    PG8_WAIT_V(0);
    if constexpr (!ALIGN_EPI) { if (wr == 0) PG8_BAR; }
    PG8_BAR;
    if constexpr (Epi::AFTER_DRAIN) { E.fused(acc, cur, wr, wc, fr, fq, lds, wid, lane); S.done(cur); }
#undef PG8_SA
#undef PG8_SB
#undef PG8_STAGE
#undef PG8_LDA
#undef PG8_LDB
#undef PG8_MMA
#undef PG8_WAIT_V
#undef PG8_WAIT_L
#undef PG8_BAR
#undef PG8_SCHED
}
}
using pg8::bf16_t; using pg8::bf16x8; using pg8::f32x4; using pg8::u32x4;

constexpr int NB = 8, SEQ = 2048, DM = 2048, NMETA = 16, LTOT = 2064, HD = 128, NH = 8;
constexpr int MR = NB * SEQ;
constexpr int MPAD = 16640;
constexpr int NWIDE = 8192, NPAD = 8448;
constexpr int NCH = 33;
constexpr int LP = 2112;
constexpr int COL_GQ = 0, COL_GK = 1024, COL_GV = 2048, COL_GZ = 3072, COL_FQ = 4096, COL_FK = 5120, COL_FV = 6144, COL_FG = 7168;
constexpr float EPSF = 1e-6f;
constexpr float LOG2E = 1.4426950408889634f;

constexpr size_t MiB = 1024 * 1024;
constexpr size_t WS_XN = 0;
constexpr size_t WS_WINT = 65 * MiB;
constexpr size_t WS_U = 0;
constexpr size_t WS_W = 33 * MiB;
constexpr size_t WS_WOUTT = 104 * MiB;
constexpr size_t WS_PROJ = 112 * MiB;
constexpr size_t WS_OUT = 112 * MiB;
constexpr size_t WS_NARROW = 372 * MiB;
constexpr size_t WS_RK = 375 * MiB;
constexpr size_t WS_FK = 376 * MiB;
constexpr size_t WS_FVT = 408 * MiB;
constexpr size_t WS_KDT = 441 * MiB;
constexpr size_t WS_C2 = 474 * MiB;
constexpr size_t WS_DECAY = 475 * MiB;
constexpr size_t WS_CTR = 476 * MiB;
constexpr size_t WS_BAR = 476 * MiB + 65536;
constexpr size_t WS_END = 477 * MiB;
constexpr size_t DO_MERGED = 0, DO_QD = 64 * MiB, DO_AQK = 97 * MiB;
#ifndef REP1
#define REP1 1
#endif
#ifndef REP2
#define REP2 1
#endif
#ifndef REP3
#define REP3 1
#endif
constexpr int LDS_BYTES = 156160;
constexpr int L_QW = 155136;

struct Params {
    const float* x; const float* meta; const float* pre_w; const float* w_in; const float* conv_w; const float* a_log; const float* dt_bias;
    const float* gdn_norm_w; const float* fq_w; const float* fk_w; const float* f_bias; const float* w_out; const float* post_w;
    float* out; unsigned char* ws;
};

typedef __bf16 bf16n2 __attribute__((ext_vector_type(2)));
typedef float f32x2 __attribute__((ext_vector_type(2)));
DI unsigned pk2(float lo, float hi) { const f32x2 v = {lo, hi}; return __builtin_bit_cast(unsigned, __builtin_convertvector(v, bf16n2)); }
DI unsigned f2bf(float x) { return pk2(x, 0.f) & 0xffffu; }
DI float bflo(unsigned u) { return __uint_as_float(u << 16); }
DI float bfhi(unsigned u) { return __uint_as_float(u & 0xffff0000u); }
DI float bf2f(bf16_t b) { return __uint_as_float(((unsigned)b) << 16); }
DI float wave_sum(float v);
template <int CTRL> DI float dppf(float x) { return __int_as_float(__builtin_amdgcn_update_dpp(0, __float_as_int(x), CTRL, 0xf, 0xf, true)); }
DI float sum4_dpp(float x) { x += dppf<0xB1>(x); x += dppf<0x4E>(x); return x; }
DI float sum16_dpp(float x) { x = sum4_dpp(x); x += dppf<0x141>(x); x += dppf<0x140>(x); return x; }
DI float xhalf_max(float x) { const u32x2 rr = __builtin_amdgcn_permlane32_swap(__float_as_uint(x), __float_as_uint(x), false, false); return fmaxf(__uint_as_float(rr[0]), __uint_as_float(rr[1])); }
DI float xhalf_sum(float x) { const u32x2 rr = __builtin_amdgcn_permlane32_swap(__float_as_uint(x), __float_as_uint(x), false, false); return __uint_as_float(rr[0]) + __uint_as_float(rr[1]); }
template <int CTRL, int RM, bool BC> DI float dppx(float x) { return __int_as_float(__builtin_amdgcn_update_dpp(0, __float_as_int(x), CTRL, RM, 0xf, BC)); }
DI float scan64_dpp(float v) {
    v += dppx<0x111, 0xf, true>(v); v += dppx<0x112, 0xf, true>(v); v += dppx<0x114, 0xf, true>(v); v += dppx<0x118, 0xf, true>(v);
    v += dppx<0x142, 0xa, false>(v); v += dppx<0x143, 0xc, false>(v); return v; }
DI float lane_bcast(float x, int l) { return __int_as_float(__builtin_amdgcn_readlane(__float_as_int(x), l)); }
DI float wave_sum(float v) { v = sum16_dpp(v); return (lane_bcast(v, 0) + lane_bcast(v, 16)) + (lane_bcast(v, 32) + lane_bcast(v, 48)); }
DI float sigmoidf_(float x) { return __builtin_amdgcn_rcpf(1.f + __expf(-x)); }
DI float siluf_(float x) { return x * __builtin_amdgcn_rcpf(1.f + __expf(-x)); }
DI float softplusf_(float x) { return x > 20.f ? x : __logf(1.f + __expf(x)); }
DI int rowof(int b, int p) { return p < NMETA ? MR + p : b * SEQ + (p - NMETA); }
DI int crow(int t, int hh) { return (t & 3) + 8 * (t >> 2) + 4 * hh; }
DI bf16x8 pack8(const f32x16& x, int s) {
    u32x4 p;
    p[0] = pk2(x[8 * s + 0], x[8 * s + 1]); p[1] = pk2(x[8 * s + 2], x[8 * s + 3]); p[2] = pk2(x[8 * s + 4], x[8 * s + 5]); p[3] = pk2(x[8 * s + 6], x[8 * s + 7]);
    return __builtin_bit_cast(bf16x8, p);
}
#define LDS_BARRIER() do { asm volatile("s_waitcnt lgkmcnt(0)" ::: "memory"); __builtin_amdgcn_s_barrier(); asm volatile("" ::: "memory"); } while (0)
#define CB() asm volatile("" ::: "memory")
#define MFMA32(a, b, c) __builtin_amdgcn_mfma_f32_32x32x16_bf16((a), (b), (c), 0, 0, 0)
DI bf16x8 ldfrag_perm(const bf16_t* rowp, int k0, int hh) {
    const u32x2 a = *(const u32x2*)(rowp + k0 + 4 * hh), b = *(const u32x2*)(rowp + k0 + 8 + 4 * hh);
    u32x4 p; p[0] = a[0]; p[1] = a[1]; p[2] = b[0]; p[3] = b[1];
    return __builtin_bit_cast(bf16x8, p);
}
struct EpiProj {
    static constexpr bool PERM = true, AFTER_DRAIN = false;
    bf16_t* P; float* narrow;
    DI void operator()(const f32x4 (&acc)[2][2][4][2], const pg8::Unit& u, int wr, int wc, int fr, int fq) const {
        const int row0 = u.pm * 256 + wr * 64 + fr;
        if (u.pn < 32) {
            const int col0 = u.pn * 256 + wc * 32 + 8 * fq;
            const bool gate = (u.pn >= 12 && u.pn < 16) || (u.pn >= 28);
#pragma unroll
            for (int ai = 0; ai < 2; ++ai)
#pragma unroll
                for (int m = 0; m < 4; ++m) { bf16_t* rowp = P + (size_t)(row0 + ai * 128 + m * 16) * NWIDE + col0;
#pragma unroll
                    for (int bj = 0; bj < 2; ++bj) { f32x4 v0 = acc[ai][bj][m][0], v1 = acc[ai][bj][m][1];
                        if (gate) {
#pragma unroll
                            for (int e = 0; e < 4; ++e) { v0[e] = siluf_(v0[e]); v1[e] = siluf_(v1[e]); } }
                        u32x4 w; w.x = pk2(v0[0], v0[1]); w.y = pk2(v0[2], v0[3]); w.z = pk2(v1[0], v1[1]); w.w = pk2(v1[2], v1[3]);
                        *(u32x4*)(rowp + bj * 128) = w; } }
        } else if (wc == 0) {
#pragma unroll
            for (int ai = 0; ai < 2; ++ai)
#pragma unroll
                for (int m = 0; m < 4; ++m) { float* rp = narrow + (size_t)(row0 + ai * 128 + m * 16) * 32 + 8 * fq;
                    *(f32x4*)rp = acc[ai][0][m][0]; *(f32x4*)(rp + 4) = acc[ai][0][m][1]; }
        }
    }
};
struct EpiOut {
    static constexpr bool PERM = true, AFTER_DRAIN = false;
    bf16_t* C;
    DI void operator()(const f32x4 (&acc)[2][2][4][2], const pg8::Unit& u, int wr, int wc, int fr, int fq) const {
        const int row0 = u.pm * 256 + wr * 64 + fr, col0 = u.pn * 256 + wc * 32 + 8 * fq;
#pragma unroll
        for (int ai = 0; ai < 2; ++ai)
#pragma unroll
            for (int m = 0; m < 4; ++m) { bf16_t* rowp = C + (size_t)(row0 + ai * 128 + m * 16) * DM + col0;
#pragma unroll
                for (int bj = 0; bj < 2; ++bj) { const f32x4 v0 = acc[ai][bj][m][0], v1 = acc[ai][bj][m][1];
                    u32x4 w; w.x = pk2(v0[0], v0[1]); w.y = pk2(v0[2], v0[3]); w.z = pk2(v1[0], v1[1]); w.w = pk2(v1[2], v1[3]);
                    *(u32x4*)(rowp + bj * 128) = w; } }
    }
};

DI void p0_rmsnorm_rows(const Params& p, int gw, int ngw, int lane) {
    bf16_t* xn = (bf16_t*)(p.ws + WS_XN);
    f32x4 w[8];
#pragma unroll
    for (int j = 0; j < 8; ++j) w[j] = ((const f32x4*)p.pre_w)[lane + 64 * j];
    f32x4 v[8], vnx[8];
    int row = gw;
    if (row < MR + NMETA) { const float* src = row < MR ? p.x + (size_t)row * DM : p.meta + (size_t)(row - MR) * DM;
#pragma unroll
        for (int j = 0; j < 8; ++j) v[j] = __builtin_nontemporal_load((const f32x4*)src + lane + 64 * j); }
    for (; row < MR + NMETA; row += ngw) {
        const int nrow = row + ngw;
        if (nrow < MR + NMETA) { const float* src = nrow < MR ? p.x + (size_t)nrow * DM : p.meta + (size_t)(nrow - MR) * DM;
#pragma unroll
            for (int j = 0; j < 8; ++j) vnx[j] = __builtin_nontemporal_load((const f32x4*)src + lane + 64 * j); }
        float ss = 0.f;
#pragma unroll
        for (int j = 0; j < 8; ++j) ss += v[j][0] * v[j][0] + v[j][1] * v[j][1] + v[j][2] * v[j][2] + v[j][3] * v[j][3];
        ss = wave_sum(ss);
        const float rstd = rsqrtf(ss * (1.f / DM) + EPSF);
#pragma unroll
        for (int j = 0; j < 8; ++j) {
            u32x2 o; o[0] = pk2(v[j][0] * rstd * w[j][0], v[j][1] * rstd * w[j][1]); o[1] = pk2(v[j][2] * rstd * w[j][2], v[j][3] * rstd * w[j][3]);
            *(u32x2*)(xn + (size_t)row * DM + 4 * (lane + 64 * j)) = o; }
#pragma unroll
        for (int j = 0; j < 8; ++j) v[j] = vnx[j];
    }
}
DI int remap_in_col(int c) {
    if (c < 4096) return c;
    if (c < 4112) return NWIDE + (c - 4096);
    if (c < 8208) return c - 16;
    return NWIDE + 16 + (c - 8208);
}
DI void p0_transpose_item(const float* src, int ncols, int k0, int n0, bf16_t* dst, bool remap, LAS float* scr, int lane) {
    const int col = n0 + (lane & 31);
    float v[32];
#pragma unroll
    for (int i = 0; i < 32; ++i) { const int kk = 2 * i + (lane >> 5); v[i] = col < ncols ? __builtin_nontemporal_load(src + (size_t)(k0 + kk) * ncols + col) : 0.f; }
#pragma unroll
    for (int i = 0; i < 32; ++i) { const int kk = 2 * i + (lane >> 5); scr[kk * 33 + (lane & 31)] = v[i]; }
    CB();
    const int c = lane & 7;
#pragma unroll
    for (int j = 0; j < 4; ++j) { const int n = (lane >> 3) + 8 * j, cc = n0 + n; const LAS float* t = scr + (8 * c) * 33 + n;
        u32x4 o; o.x = pk2(t[0], t[33]); o.y = pk2(t[2 * 33], t[3 * 33]); o.z = pk2(t[4 * 33], t[5 * 33]); o.w = pk2(t[6 * 33], t[7 * 33]);
        if (cc < ncols) *(u32x4*)(dst + (size_t)(remap ? remap_in_col(cc) : cc) * 2048 + k0 + 8 * c) = o; }
    CB();
}
DI void phase0(const Params& p, LAS unsigned char* lds, int tid, int wid, int lane) {
    if (blockIdx.x == 0 && tid < 64) ((unsigned*)(p.ws + WS_CTR))[tid] = 0u;
    const int gw = blockIdx.x * 8 + wid, ngw = gridDim.x * 8;
    p0_rmsnorm_rows(p, gw, ngw, lane);
    constexpr int NB_IN = (8216 + 31) / 32;
    constexpr int I_IN = 32 * NB_IN, I_OUT = 32 * 64;
    LAS float* scr = (LAS float*)lds + wid * (64 * 33);
    for (int it = gw; it < I_IN + I_OUT; it += ngw) {
        if (it < I_IN) p0_transpose_item(p.w_in, 8216, 64 * (it / NB_IN), 32 * (it % NB_IN), (bf16_t*)(p.ws + WS_WINT), true, scr, lane);
        else { const int u = it - I_IN; p0_transpose_item(p.w_out, 2048, 64 * (u >> 6), 32 * (u & 63), (bf16_t*)(p.ws + WS_WOUTT), false, scr, lane); }
    }
}
constexpr int L_QH = 0, L_KH = 17408, L_VB = 34816, L_KB = 52224, L_NM = 69632, L_TM = 87040, L_GS = 96256, L_BS = 96512;
DI bf16x8 tr_pair(const LAS unsigned char* lo, const LAS unsigned char* hi) {
    const s16x4 a = __builtin_amdgcn_ds_read_tr16_b64_v4i16((LAS s16x4*)lo), b = __builtin_amdgcn_ds_read_tr16_b64_v4i16((LAS s16x4*)hi);
    return __builtin_shufflevector(a, b, 0, 1, 2, 3, 4, 5, 6, 7);
}
DI bf16x8 ldsfrag_perm(const LAS unsigned char* rowp, int k0, int hh) {
    const u32x2 a = *(const LAS u32x2*)(rowp + 2 * (k0 + 4 * hh)), b = *(const LAS u32x2*)(rowp + 2 * (k0 + 8 + 4 * hh));
    u32x4 p; p[0] = a[0]; p[1] = a[1]; p[2] = b[0]; p[3] = b[1];
    return __builtin_bit_cast(bf16x8, p);
}
struct PrepRegs { u32x4 xr[11]; f32x4 w[8]; u32x4 fkv[2]; float pn0, pn1; };
DI void prep_loads(const Params& p, int task, int tid, int wid, int lane, PrepRegs& R) {
    const int bh = task / NCH, ch = task % NCH, b = bh >> 3, h = bh & 7;
    const bf16_t* proj = (const bf16_t*)(p.ws + WS_PROJ); const float* narrow = (const float*)(p.ws + WS_NARROW);
    const int nvalid = ch == 0 ? NMETA : 64, pbase = ch == 0 ? 0 : NMETA + 64 * (ch - 1);
    const int cgp = tid & 15, seg = (tid >> 4) & 7, m = __builtin_amdgcn_readfirstlane(tid >> 7);
    const int ch0 = m * 1024 + h * 128 + cgp * 8;
    if (m < 3) {
#pragma unroll
        for (int e = 0; e < 8; ++e) R.w[e] = *(const f32x4*)(p.conv_w + (size_t)(ch0 + e) * 4);
#pragma unroll
        for (int j = 0; j < 11; ++j) { const int i = 8 * seg - 3 + j, pp = pbase + i;
            R.xr[j] = (u32x4){0u, 0u, 0u, 0u};
            if (pp >= 0 && i < nvalid) R.xr[j] = *(const u32x4*)(proj + (size_t)rowof(b, pp) * NWIDE + ch0); }
    }
#pragma unroll
    for (int it = 0; it < 2; ++it) { const int item = tid + 512 * it, i = item >> 4;
        R.fkv[it] = (u32x4){0u, 0u, 0u, 0u};
        if (i < nvalid) R.fkv[it] = *(const u32x4*)(proj + (size_t)rowof(b, pbase + i) * NWIDE + COL_FK + h * 128 + (item & 15) * 8); }
    R.pn0 = 0.f; R.pn1 = 0.f;
    if (wid == 0 && lane < nvalid) { const float* nr = narrow + (size_t)rowof(b, pbase + lane) * 32; R.pn0 = nr[h]; R.pn1 = nr[8 + h]; }
}
DI void gdn_prep_task(const Params& p, LAS unsigned char* lds, int task, int next_task, int tid, int wid, int lane, PrepRegs& R) {
    const int bh = task / NCH, ch = task % NCH, b = bh >> 3, h = bh & 7;
    const size_t cb = (size_t)bh * NCH + ch;
    bf16_t* Ug = (bf16_t*)(p.ws + WS_U); bf16_t* Wg = (bf16_t*)(p.ws + WS_W); bf16_t* kdg = (bf16_t*)(p.ws + WS_KDT);
    bf16_t* qdg = (bf16_t*)((unsigned char*)p.out + DO_QD); bf16_t* aqkg = (bf16_t*)((unsigned char*)p.out + DO_AQK);
    LAS float* Nm = (LAS float*)(lds + L_NM); LAS bf16_t* Tm = (LAS bf16_t*)(lds + L_TM); LAS float* Gs = (LAS float*)(lds + L_GS); LAS float* Bs = (LAS float*)(lds + L_BS);
    const int nvalid = ch == 0 ? NMETA : 64, pbase = ch == 0 ? 0 : NMETA + 64 * (ch - 1);
    const int cgp = tid & 15, seg = (tid >> 4) & 7, m = __builtin_amdgcn_readfirstlane(tid >> 7);
    if (wid == 0) {
        float beta = 0.f, g = 0.f;
        if (lane < nvalid) { beta = sigmoidf_(R.pn0); g = -__expf(p.a_log[h]) * softplusf_(R.pn1 + p.dt_bias[h]); }
        const float G = scan64_dpp(g);
        Gs[lane] = G; Bs[lane] = beta;
    }
    __syncthreads();
    const float Gl = Gs[63];
    if (tid == 0) ((float*)(p.ws + WS_DECAY))[cb] = __expf(Gl);
#pragma unroll
    for (int it = 0; it < 2; ++it) { const int item = tid + 512 * it, i = item >> 4;
        float ss = 0.f;
#pragma unroll
        for (int e2 = 0; e2 < 4; ++e2) { const float lo = bflo(R.fkv[it][e2]), hi = bfhi(R.fkv[it][e2]); ss += lo * lo + hi * hi; }
        ss = sum16_dpp(ss);
        if ((item & 15) == 0 && i < nvalid) ((float*)(p.ws + WS_RK))[(size_t)bh * LP + pbase + i] = rsqrtf(ss * (1.f / HD) + EPSF); }
    if (m < 3) {
        float Gv[8], Bv[8];
        { const f32x4 g0 = *(const LAS f32x4*)(Gs + 8 * seg), g1 = *(const LAS f32x4*)(Gs + 8 * seg + 4), b0 = *(const LAS f32x4*)(Bs + 8 * seg), b1 = *(const LAS f32x4*)(Bs + 8 * seg + 4);
#pragma unroll
          for (int e = 0; e < 4; ++e) { Gv[e] = g0[e]; Gv[4 + e] = g1[e]; Bv[e] = b0[e]; Bv[4 + e] = b1[e]; } }
        float xf[11][8];
#pragma unroll
        for (int j = 0; j < 11; ++j)
#pragma unroll
            for (int e2 = 0; e2 < 4; ++e2) { xf[j][2 * e2] = bflo(R.xr[j][e2]); xf[j][2 * e2 + 1] = bfhi(R.xr[j][e2]); }
#pragma unroll
        for (int u = 0; u < 8; ++u) {
            const int i = 8 * seg + u;
            float y[8];
#pragma unroll
            for (int e = 0; e < 8; ++e) y[e] = 0.f;
#pragma unroll
            for (int j = 0; j < 4; ++j)
#pragma unroll
                for (int e = 0; e < 8; ++e) y[e] += xf[u + j][e] * R.w[e][j];
            if (i >= nvalid) {
#pragma unroll
                for (int e = 0; e < 8; ++e) y[e] = 0.f;
            }
#pragma unroll
            for (int e = 0; e < 8; ++e) y[e] = siluf_(y[e]);
            const float Gi = Gv[u], bi = Bv[u];
            if (m < 2) {
                float ss = 0.f;
#pragma unroll
                for (int e = 0; e < 8; ++e) ss += y[e] * y[e];
                ss = sum16_dpp(ss);
                const float rn = __builtin_amdgcn_rsqf(ss + EPSF) * (m == 0 ? 0.08838834764831845f : 1.f);
#pragma unroll
                for (int e = 0; e < 8; ++e) y[e] *= rn;
            }
            u32x4 o; o.x = pk2(y[0], y[1]); o.y = pk2(y[2], y[3]); o.z = pk2(y[4], y[5]); o.w = pk2(y[6], y[7]);
            if (m == 0) {
                *(LAS u32x4*)(lds + L_QH + i * 272 + cgp * 16) = o;
                const float eg = __expf(Gi);
                o.x = pk2(y[0] * eg, y[1] * eg); o.y = pk2(y[2] * eg, y[3] * eg); o.z = pk2(y[4] * eg, y[5] * eg); o.w = pk2(y[6] * eg, y[7] * eg);
                *(u32x4*)(qdg + cb * 8192 + i * 128 + cgp * 8) = o;
            } else if (m == 1) {
                *(LAS u32x4*)(lds + L_KH + i * 272 + cgp * 16) = o;
                const float f1 = bi * __expf(Gi), f2 = __expf(Gl - Gi);
                o.x = pk2(y[0] * f1, y[1] * f1); o.y = pk2(y[2] * f1, y[3] * f1); o.z = pk2(y[4] * f1, y[5] * f1); o.w = pk2(y[6] * f1, y[7] * f1);
                *(LAS u32x4*)(lds + L_KB + i * 272 + cgp * 16) = o;
                o.x = pk2(y[0] * f2, y[1] * f2); o.y = pk2(y[2] * f2, y[3] * f2); o.z = pk2(y[4] * f2, y[5] * f2); o.w = pk2(y[6] * f2, y[7] * f2);
                *(u32x4*)(kdg + cb * 8192 + i * 128 + cgp * 8) = o;
            } else {
                o.x = pk2(y[0] * bi, y[1] * bi); o.y = pk2(y[2] * bi, y[3] * bi); o.z = pk2(y[4] * bi, y[5] * bi); o.w = pk2(y[6] * bi, y[7] * bi);
                *(LAS u32x4*)(lds + L_VB + i * 272 + cgp * 16) = o;
            }
        }
    }
    __syncthreads();
    const int r = lane & 31, hh = lane >> 5;
    const int i16 = lane & 15, tq = i16 >> 2, tp = i16 & 3, tblk = (lane >> 4) & 1;
    if (next_task >= 0) prep_loads(p, next_task, tid, wid, lane, R);
    for (int idx = tid; idx < 576; idx += 512) *(LAS u32x4*)(lds + L_TM + 16 * idx) = (u32x4){0u, 0u, 0u, 0u};
    {
        const bool isqk = wid >= 4; const int mi = (wid >> 1) & 1, ni = wid & 1;
        const LAS unsigned char* Ap = lds + (isqk ? L_QH : L_KH) + (32 * mi + r) * 272 + 16 * hh; const LAS unsigned char* Bp = lds + L_KH + (32 * ni + r) * 272 + 16 * hh;
        f32x16 acc;
#pragma unroll
        for (int t = 0; t < 16; ++t) acc[t] = 0.f;
#pragma unroll
        for (int ks = 0; ks < 8; ++ks) acc = MFMA32(*(const LAS bf16x8*)(Ap + 32 * ks), *(const LAS bf16x8*)(Bp + 32 * ks), acc);
        const int j = 32 * ni + r; const float Gj = Gs[j];
        const int i0 = 32 * mi + 4 * hh;
        if (!isqk) {
#pragma unroll
            for (int g = 0; g < 4; ++g) { const f32x4 Gi = *(const LAS f32x4*)(Gs + i0 + 8 * g), Bi = *(const LAS f32x4*)(Bs + i0 + 8 * g);
#pragma unroll
                for (int e = 0; e < 4; ++e) { const int i = i0 + 8 * g + e; Nm[i * 68 + j] = (j < i) ? Bi[e] * acc[4 * g + e] * __expf(Gi[e] - Gj) : 0.f; } }
        } else {
            bf16_t* ao = aqkg + cb * 4096 + j;
#pragma unroll
            for (int g = 0; g < 4; ++g) { const f32x4 Gi = *(const LAS f32x4*)(Gs + i0 + 8 * g);
#pragma unroll
                for (int e = 0; e < 4; ++e) { const int i = i0 + 8 * g + e; ao[i * 64] = (bf16_t)f2bf((j <= i) ? acc[4 * g + e] * __expf(Gi[e] - Gj) : 0.f); } }
        }
    }
    __syncthreads();
    if (wid == 0) {
        {
            const int blk = lane >> 4, c = lane & 15;
            float t[16];
            const LAS float* nb = Nm + (16 * blk) * 68 + 16 * blk;
#pragma unroll
            for (int i = 0; i < 16; ++i) {
                float a = (i == c) ? 1.f : 0.f, a2 = 0.f;
#pragma unroll
                for (int j4 = 0; j4 < (i + 3) / 4; ++j4) { const f32x4 nv = *(const LAS f32x4*)(nb + i * 68 + 4 * j4);
#pragma unroll
                    for (int e = 0; e < 4; ++e) if (4 * j4 + e < i) { if (e & 1) a2 -= nv[e] * t[4 * j4 + e]; else a -= nv[e] * t[4 * j4 + e]; } }
                a += a2;
                if ((i & 3) == 3) asm volatile("" : "+v"(a) :: "memory");
                t[i] = a;
            }
#pragma unroll
            for (int i = 0; i < 16; ++i) Tm[(16 * blk + i) * 72 + 16 * blk + c] = (bf16_t)f2bf(t[i]);
        }
        {
            const int half = r >> 4, rl = r & 15;
            const LAS float* np = Nm + (16 + 32 * half + rl) * 68 + 32 * half + 8 * hh;
            const f32x4 n0 = *(const LAS f32x4*)np, n1 = *(const LAS f32x4*)(np + 4);
            u32x4 ap; ap.x = pk2(n0[0], n0[1]); ap.y = pk2(n0[2], n0[3]); ap.z = pk2(n1[0], n1[1]); ap.w = pk2(n1[2], n1[3]);
            const LAS unsigned char* tb = lds + L_TM + (32 * tblk + 8 * hh + tq) * 144 + (32 * tblk + 4 * tp) * 2;
            f32x16 X1;
#pragma unroll
            for (int tt = 0; tt < 16; ++tt) X1[tt] = 0.f;
            X1 = MFMA32(__builtin_bit_cast(bf16x8, ap), tr_pair(tb, tb + 4 * 144), X1);
            const u32x4 x0 = __builtin_bit_cast(u32x4, pack8(X1, 0)), x1 = __builtin_bit_cast(u32x4, pack8(X1, 1));
            u32x4 xs; xs.x = half ? x1.x : x0.x; xs.y = half ? x1.y : x0.y; xs.z = half ? x1.z : x0.z; xs.w = half ? x1.w : x0.w;
            const LAS unsigned char* d1 = lds + L_TM + (16 + 32 * half + rl) * 144;
            f32x16 Y;
#pragma unroll
            for (int tt = 0; tt < 16; ++tt) Y[tt] = 0.f;
            Y = MFMA32(ldsfrag_perm(d1, 16 + 32 * half, hh), __builtin_bit_cast(bf16x8, xs), Y);
#pragma unroll
            for (int tt = 0; tt < 16; ++tt) { const int rowl = crow(tt, hh); if ((rowl >> 4) == half) Tm[(16 + 32 * half + (rowl & 15)) * 72 + 32 * half + rl] = (bf16_t)f2bf(-Y[tt]); }
        }
        f32x16 X;
#pragma unroll
        for (int tt = 0; tt < 16; ++tt) X[tt] = 0.f;
#pragma unroll
        for (int s2 = 0; s2 < 2; ++s2) {
            const LAS float* np = Nm + (32 + r) * 68 + 16 * s2 + 8 * hh;
            const f32x4 n0 = *(const LAS f32x4*)np, n1 = *(const LAS f32x4*)(np + 4);
            u32x4 ap; ap.x = pk2(n0[0], n0[1]); ap.y = pk2(n0[2], n0[3]); ap.z = pk2(n1[0], n1[1]); ap.w = pk2(n1[2], n1[3]);
            const LAS unsigned char* tb = lds + L_TM + (16 * s2 + 8 * hh + tq) * 144 + (16 * tblk + 4 * tp) * 2;
            X = MFMA32(__builtin_bit_cast(bf16x8, ap), tr_pair(tb, tb + 4 * 144), X);
        }
        f32x16 R;
#pragma unroll
        for (int tt = 0; tt < 16; ++tt) R[tt] = 0.f;
        const LAS unsigned char* t22 = lds + L_TM + (32 + r) * 144;
        R = MFMA32(ldsfrag_perm(t22, 32, hh), pack8(X, 0), R);
        R = MFMA32(ldsfrag_perm(t22, 48, hh), pack8(X, 1), R);
#pragma unroll
        for (int tt = 0; tt < 16; ++tt) Tm[(32 + crow(tt, hh)) * 72 + r] = (bf16_t)f2bf(-R[tt]);
    }
    __syncthreads();
#pragma unroll
    for (int q = 0; q < 2; ++q) {
        const int id = 2 * wid + q, X = id >> 3, mt = (id & 7) >> 1, nt = id & 1;
        const LAS unsigned char* img = lds + (X ? L_KB : L_VB) + (8 * hh + tq) * 272 + (32 * mt + 16 * tblk + 4 * tp) * 2;
        const LAS unsigned char* Bp = lds + L_TM + (32 * nt + r) * 144 + 16 * hh;
        f32x16 acc;
#pragma unroll
        for (int t = 0; t < 16; ++t) acc[t] = 0.f;
#pragma unroll
        for (int ks = 0; ks < 4; ++ks) { const bf16x8 fa = tr_pair(img + (16 * ks) * 272, img + (16 * ks + 4) * 272), fb = *(const LAS bf16x8*)(Bp + 32 * ks); acc = X ? MFMA32(fa, fb, acc) : MFMA32(fb, fa, acc); }
        bf16_t* dst = X ? Wg + cb * 8192 + (32 * nt + r) * 128 + 32 * mt + 4 * hh : Ug + cb * 8192 + (32 * mt + r) * 64 + 32 * nt + 4 * hh;
#pragma unroll
        for (int g = 0; g < 4; ++g) { u32x2 o; o[0] = pk2(acc[4 * g], acc[4 * g + 1]); o[1] = pk2(acc[4 * g + 2], acc[4 * g + 3]); *(u32x2*)(dst + 8 * g) = o; }
    }
    __syncthreads();
}
DI void fox_prep_task(const Params& p, LAS unsigned char* lds, int task, int tid) {
    const int bh = task / 33, tile = task % 33, b = bh >> 3, h = bh & 7, p0 = 64 * tile;
    const bf16_t* proj = (const bf16_t*)(p.ws + WS_PROJ);
    float* rk = (float*)(p.ws + WS_RK);
    u32x4 kv[2];
#pragma unroll
    for (int it = 0; it < 2; ++it) { const int item = tid + 512 * it, i = item >> 4, cgp = item & 15, pos = p0 + i;
        kv[it] = (u32x4){0u, 0u, 0u, 0u};
        if (pos < LTOT) kv[it] = *(const u32x4*)(proj + (size_t)rowof(b, pos) * NWIDE + COL_FK + h * 128 + cgp * 8); }
#pragma unroll
    for (int it = 0; it < 2; ++it) { const int item = tid + 512 * it, i = item >> 4, cgp = item & 15, pos = p0 + i;
        float ss = 0.f;
#pragma unroll
        for (int e2 = 0; e2 < 4; ++e2) { const float lo = bflo(kv[it][e2]), hi = bfhi(kv[it][e2]); ss += lo * lo + hi * hi; }
        ss = sum16_dpp(ss);
        if (cgp == 0) rk[(size_t)bh * LP + pos] = rsqrtf(ss * (1.f / HD) + EPSF); }
}
DI void cumsum_task(const Params& p, int bh, int lane) {
    const int b = bh >> 3, h = bh & 7; const float* narrow = (const float*)(p.ws + WS_NARROW); float* c2 = (float*)(p.ws + WS_C2);
    const float bias = p.f_bias[h]; float carry = 0.f;
    if (LTOT + lane < LP) ((float*)(p.ws + WS_RK))[(size_t)bh * LP + LTOT + lane] = 1.f;
    float xs[33];
#pragma unroll
    for (int k = 0; k < 33; ++k) { const int pos = 64 * k + lane; xs[k] = pos < LTOT ? narrow[(size_t)rowof(b, pos) * 32 + 16 + h] : 0.f; }
#pragma unroll
    for (int k = 0; k < 33; ++k) {
        const int pos = 64 * k + lane; float lf = 0.f;
        if (pos < LTOT) { const float xx = xs[k] + bias; lf = fminf(xx, 0.f) - __logf(1.f + __expf(-fabsf(xx))); }
        lf = scan64_dpp(lf);
        const float c = carry + lf; c2[(size_t)bh * LP + pos] = c * LOG2E; carry = lane_bcast(c, 63);
    }
}
DI void phase2(const Params& p, LAS unsigned char* lds, int tid, int wid, int lane) {
    constexpr int NG = 64 * NCH;
    const int G = gridDim.x;
    PrepRegs R;
    int t = blockIdx.x;
    if (t < NG) prep_loads(p, t, tid, wid, lane, R);
    if ((int)blockIdx.x >= G - 8) cumsum_task(p, ((int)blockIdx.x - (G - 8)) * 8 + wid, lane);
    for (; t < NG; t += G) {
        asm volatile("" : "+v"(tid)); wid = __builtin_amdgcn_readfirstlane(tid >> 6); lane = tid & 63;
        gdn_prep_task(p, lds, t, t + G < NG ? t + G : -1, tid, wid, lane, R);
    }
}
constexpr int SB_W = 0, SB_Q = 16896, SB_A = 33792, SB_K = 42496, SB_SIZE = 59904, S_OBUF = 2 * SB_SIZE;
DI void gdn_scan_task(const Params& p, LAS unsigned char* lds, int bh, int tid, int wid, int lane) {
    const int b = bh >> 3, h = bh & 7;
    const bf16_t* Ug = (const bf16_t*)(p.ws + WS_U); const bf16_t* Wg = (const bf16_t*)(p.ws + WS_W); const bf16_t* kdg = (const bf16_t*)(p.ws + WS_KDT);
    const bf16_t* qdg = (const bf16_t*)((const unsigned char*)p.out + DO_QD); const bf16_t* aqkg = (const bf16_t*)((const unsigned char*)p.out + DO_AQK);
    const float* decay = (const float*)(p.ws + WS_DECAY);
    const bf16_t* proj = (const bf16_t*)(p.ws + WS_PROJ); bf16_t* merged = (bf16_t*)((unsigned char*)p.out + DO_MERGED);
    LAS bf16_t* obuf16 = (LAS bf16_t*)(lds + S_OBUF);
    LAS float* gws = (LAS float*)(lds + S_OBUF + 34816);
    if (tid < 128) gws[tid] = p.gdn_norm_w[tid];
    const size_t cb0 = (size_t)bh * NCH;
    if (wid < 4) {
        const int sl = wid, r = lane & 31, hh = lane >> 5;
        const int i16 = lane & 15, tq = i16 >> 2, tp = i16 & 3, tblk = (lane >> 4) & 1;
        f32x16 S[4];
#pragma unroll
        for (int kt = 0; kt < 4; ++kt)
#pragma unroll
            for (int t = 0; t < 16; ++t) S[kt][t] = 0.f;
        u32x2 ureg[8]; float dec;
        { const bf16_t* Uc = Ug + cb0 * 8192 + (32 * sl + r) * 64 + 4 * hh;
#pragma unroll
          for (int q8 = 0; q8 < 8; ++q8) ureg[q8] = *(const u32x2*)(Uc + 32 * (q8 >> 2) + 8 * (q8 & 3));
          dec = decay[cb0]; }
        for (int c = 0; c <= NCH; ++c) {
            LDS_BARRIER();
            if (c == NCH) break;
            const LAS unsigned char* sb = lds + (c & 1) * SB_SIZE;
            const LAS unsigned char* rw0 = sb + SB_W + r * 264; const LAS unsigned char* rw1 = rw0 + 32 * 264;
            const LAS unsigned char* rq0 = sb + SB_Q + r * 264; const LAS unsigned char* rq1 = rq0 + 32 * 264;
            const LAS unsigned char* ra0 = sb + SB_A + r * 136; const LAS unsigned char* ra1 = ra0 + 32 * 136;
            const LAS unsigned char* kbase = sb + SB_K + (4 * hh + tq) * 272 + (16 * tblk + 4 * tp) * 2;
            bf16x8 fa[8], fb[8];
#define SBF(ks) pack8(S[(ks) >> 1], (ks) & 1)
#pragma unroll
            for (int k4 = 0; k4 < 4; ++k4) { fa[k4] = ldsfrag_perm(rw0, 16 * k4, hh); fa[4 + k4] = ldsfrag_perm(rw1, 16 * k4, hh); }
            CB();
#pragma unroll
            for (int k4 = 0; k4 < 4; ++k4) { fb[k4] = ldsfrag_perm(rw0, 64 + 16 * k4, hh); fb[4 + k4] = ldsfrag_perm(rw1, 64 + 16 * k4, hh); }
            f32x16 acc0, acc1, o0, o1;
#pragma unroll
            for (int t = 0; t < 16; ++t) { acc0[t] = 0.f; acc1[t] = 0.f; o0[t] = 0.f; o1[t] = 0.f; }
#pragma unroll
            for (int k4 = 0; k4 < 4; ++k4) { acc0 = MFMA32(fa[k4], SBF(k4), acc0); acc1 = MFMA32(fa[4 + k4], SBF(k4), acc1); }
            CB();
#pragma unroll
            for (int k4 = 0; k4 < 4; ++k4) { fa[k4] = ldsfrag_perm(rq0, 16 * k4, hh); fa[4 + k4] = ldsfrag_perm(rq1, 16 * k4, hh); }
#pragma unroll
            for (int k4 = 0; k4 < 4; ++k4) { acc0 = MFMA32(fb[k4], SBF(4 + k4), acc0); acc1 = MFMA32(fb[4 + k4], SBF(4 + k4), acc1); }
            CB();
#pragma unroll
            for (int k4 = 0; k4 < 4; ++k4) { fb[k4] = ldsfrag_perm(rq0, 64 + 16 * k4, hh); fb[4 + k4] = ldsfrag_perm(rq1, 64 + 16 * k4, hh); }
#pragma unroll
            for (int k4 = 0; k4 < 4; ++k4) { o0 = MFMA32(fa[k4], SBF(k4), o0); o1 = MFMA32(fa[4 + k4], SBF(k4), o1); }
            CB();
#pragma unroll
            for (int js = 0; js < 4; ++js) { if (js < 2) fa[js] = ldsfrag_perm(ra0, 16 * js, hh); fa[4 + js] = ldsfrag_perm(ra1, 16 * js, hh); }
#pragma unroll
            for (int k4 = 0; k4 < 4; ++k4) { o0 = MFMA32(fb[k4], SBF(4 + k4), o0); o1 = MFMA32(fb[4 + k4], SBF(4 + k4), o1); }
            f32x16 vn0, vn1;
#pragma unroll
            for (int g4 = 0; g4 < 4; ++g4) { const u32x2 u0 = ureg[g4], u1 = ureg[4 + g4];
                vn0[4 * g4] = bflo(u0[0]) - acc0[4 * g4]; vn0[4 * g4 + 1] = bfhi(u0[0]) - acc0[4 * g4 + 1]; vn0[4 * g4 + 2] = bflo(u0[1]) - acc0[4 * g4 + 2]; vn0[4 * g4 + 3] = bfhi(u0[1]) - acc0[4 * g4 + 3];
                vn1[4 * g4] = bflo(u1[0]) - acc1[4 * g4]; vn1[4 * g4 + 1] = bfhi(u1[0]) - acc1[4 * g4 + 1]; vn1[4 * g4 + 2] = bflo(u1[1]) - acc1[4 * g4 + 2]; vn1[4 * g4 + 3] = bfhi(u1[1]) - acc1[4 * g4 + 3]; }
            bf16x8 Vb[4];
            Vb[0] = pack8(vn0, 0); Vb[1] = pack8(vn0, 1); Vb[2] = pack8(vn1, 0); Vb[3] = pack8(vn1, 1);
            CB();
#pragma unroll
            for (int q8 = 0; q8 < 8; ++q8) { const LAS unsigned char* a0 = kbase + (16 * (q8 & 3)) * 272 + 64 * (q8 >> 2); fb[q8] = tr_pair(a0, a0 + 8 * 272); }
#pragma unroll
            for (int js = 0; js < 4; ++js) { if (js < 2) o0 = MFMA32(fa[js], Vb[js], o0); o1 = MFMA32(fa[4 + js], Vb[js], o1); }
            CB();
#pragma unroll
            for (int q8 = 0; q8 < 8; ++q8) { const LAS unsigned char* a0 = kbase + (16 * (q8 & 3)) * 272 + 64 * (2 + (q8 >> 2)); fa[q8] = tr_pair(a0, a0 + 8 * 272); }
            { f32x16 a0 = S[0] * dec, a1 = S[1] * dec;
#pragma unroll
              for (int js = 0; js < 4; ++js) { a0 = MFMA32(fb[js], Vb[js], a0); a1 = MFMA32(fb[4 + js], Vb[js], a1); }
              S[0] = a0; S[1] = a1; }
            CB();
            { f32x16 a2 = S[2] * dec, a3 = S[3] * dec;
#pragma unroll
              for (int js = 0; js < 4; ++js) { a2 = MFMA32(fa[js], Vb[js], a2); a3 = MFMA32(fa[4 + js], Vb[js], a3); }
              S[2] = a2; S[3] = a3; }
            if (c + 1 < NCH) {
                const bf16_t* Uc = Ug + (cb0 + c + 1) * 8192 + (32 * sl + r) * 64 + 4 * hh;
#pragma unroll
                for (int q8 = 0; q8 < 8; ++q8) ureg[q8] = *(const u32x2*)(Uc + 32 * (q8 >> 2) + 8 * (q8 & 3));
            }
            if (c + 1 < NCH) dec = decay[cb0 + c + 1];
            if (c > 0) {
                LAS bf16_t* ow = obuf16 + (c & 1) * (64 * 136) + 32 * sl + r;
#pragma unroll
                for (int t = 0; t < 16; ++t) { ow[crow(t, hh) * 136] = (bf16_t)f2bf(o0[t]); ow[(32 + crow(t, hh)) * 136] = (bf16_t)f2bf(o1[t]); }
            }
        }
    } else {
        const int lt = tid & 255, tok = lt >> 2, qtr = lt & 3;
        u32x4 lw[4], lq[4], lk[4], la[2], gz[4];
#define SCAN_LOAD_REGS(cbx) do { \
        _Pragma("unroll") for (int k = 0; k < 4; ++k) { const int id = lt + 256 * k, row = id >> 4, pc = id & 15; \
            lw[k] = *(const u32x4*)(Wg + (cbx) * 8192 + row * 128 + pc * 8); lq[k] = *(const u32x4*)(qdg + (cbx) * 8192 + row * 128 + pc * 8); lk[k] = *(const u32x4*)(kdg + (cbx) * 8192 + row * 128 + pc * 8); } \
        _Pragma("unroll") for (int k = 0; k < 2; ++k) { const int id = lt + 256 * k, row = id >> 3, pc = id & 7; la[k] = *(const u32x4*)(aqkg + (cbx) * 4096 + row * 64 + pc * 8); } \
    } while (0)
#define SCAN_STORE_REGS(sbx) do { \
        _Pragma("unroll") for (int k = 0; k < 4; ++k) { const int id = lt + 256 * k, row = id >> 4, pc = id & 15; \
            LAS u32x2* dw = (LAS u32x2*)((sbx) + SB_W + row * 264 + pc * 16); dw[0] = (u32x2){lw[k].x, lw[k].y}; dw[1] = (u32x2){lw[k].z, lw[k].w}; \
            LAS u32x2* dq = (LAS u32x2*)((sbx) + SB_Q + row * 264 + pc * 16); dq[0] = (u32x2){lq[k].x, lq[k].y}; dq[1] = (u32x2){lq[k].z, lq[k].w}; \
            *(LAS u32x4*)((sbx) + SB_K + row * 272 + pc * 16) = lk[k]; } \
        _Pragma("unroll") for (int k = 0; k < 2; ++k) { const int id = lt + 256 * k, row = id >> 3, pc = id & 7; \
            LAS u32x2* da = (LAS u32x2*)((sbx) + SB_A + row * 136 + pc * 16); da[0] = (u32x2){la[k].x, la[k].y}; da[1] = (u32x2){la[k].z, la[k].w}; } \
    } while (0)
        SCAN_LOAD_REGS(cb0);
        SCAN_STORE_REGS(lds);
        SCAN_LOAD_REGS(cb0 + 1);
#pragma unroll
        for (int e8 = 0; e8 < 4; ++e8) gz[e8] = (u32x4){0u, 0u, 0u, 0u};

        const LAS float* gw = gws + qtr * 32;
        for (int c = 0; c <= NCH; ++c) {
            LDS_BARRIER();
            if (c + 1 < NCH) { LAS unsigned char* sbn = lds + ((c + 1) & 1) * SB_SIZE; SCAN_STORE_REGS(sbn); }
            CB();
            if (c + 2 < NCH) SCAN_LOAD_REGS(cb0 + c + 2);
            CB();
            if (c >= 2) {
                const LAS u32x4* ob = (const LAS u32x4*)(obuf16 + ((c - 1) & 1) * (64 * 136) + tok * 136 + qtr * 32);
                u32x4 ov[4]; float ss = 0.f;
#pragma unroll
                for (int e8 = 0; e8 < 4; ++e8) { ov[e8] = ob[e8];
#pragma unroll
                    for (int e2 = 0; e2 < 4; ++e2) { const float lo = bflo(ov[e8][e2]), hi = bfhi(ov[e8][e2]); ss += lo * lo + hi * hi; } }
                ss = sum4_dpp(ss);
                const float rstd = __builtin_amdgcn_rsqf(ss * (1.f / HD) + EPSF);
                bf16_t* mp = merged + ((size_t)b * SEQ + 64 * (c - 2) + tok) * DM + h * 128 + qtr * 32;
#pragma unroll
                for (int e8 = 0; e8 < 4; ++e8) {
                    const f32x4 v0 = (f32x4){bflo(ov[e8].x), bfhi(ov[e8].x), bflo(ov[e8].y), bfhi(ov[e8].y)}, v1 = (f32x4){bflo(ov[e8].z), bfhi(ov[e8].z), bflo(ov[e8].w), bfhi(ov[e8].w)};
                    const f32x4 w0 = *(const LAS f32x4*)(gw + 8 * e8), w1 = *(const LAS f32x4*)(gw + 8 * e8 + 4);
                    const u32x4 g = gz[e8];
                    u32x4 o;
                    o.x = pk2(v0[0] * rstd * w0[0] * bflo(g.x), v0[1] * rstd * w0[1] * bfhi(g.x));
                    o.y = pk2(v0[2] * rstd * w0[2] * bflo(g.y), v0[3] * rstd * w0[3] * bfhi(g.y));
                    o.z = pk2(v1[0] * rstd * w1[0] * bflo(g.z), v1[1] * rstd * w1[1] * bfhi(g.z));
                    o.w = pk2(v1[2] * rstd * w1[2] * bflo(g.w), v1[3] * rstd * w1[3] * bfhi(g.w));
                    *(u32x4*)(mp + 8 * e8) = o;
                }
            }
            CB();
            if (c >= 1 && c < NCH) {
                const bf16_t* gzp = proj + ((size_t)b * SEQ + 64 * (c - 1) + tok) * NWIDE + COL_GZ + h * 128 + qtr * 32;
#pragma unroll
                for (int e8 = 0; e8 < 4; ++e8) gz[e8] = *(const u32x4*)(gzp + 8 * e8);
            }
        }
#undef SCAN_LOAD_REGS
#undef SCAN_STORE_REGS
    }
    __syncthreads();
}
constexpr int AB_K = 0, AB_V = 17408, AB_C = 34816, AB_R = 35072, AB_SIZE = 35328;
DI void attn_task(const Params& p, LAS unsigned char* lds, int a, int tid, int wid, int lane) {
    const int qblk = 7 - (a >> 6), bh = a & 63, b = bh >> 3, h = bh & 7, r = lane & 31, hh = lane >> 5;
    const bf16_t* proj = (const bf16_t*)(p.ws + WS_PROJ); bf16_t* merged = (bf16_t*)((unsigned char*)p.out + DO_MERGED);
    const int qs = NMETA + 256 * qblk + 32 * wid, qpos = qs + r;
    const size_t row = (size_t)b * SEQ + 256 * qblk + 32 * wid + r;
    const int nT = (271 + 256 * qblk) / 64 + 1;
    const int i16 = lane & 15, tq = i16 >> 2, tp = i16 & 3, tblk = (lane >> 4) & 1;
    u32x4 pk[2], pv[2]; f32x4 pc4 = (f32x4){0.f, 0.f, 0.f, 0.f};
    const float* cbp = (const float*)(p.ws + WS_C2) + (size_t)bh * LP;
    const float* rkp = (const float*)(p.ws + WS_RK) + (size_t)bh * LP;
    float prk[2];
#define ATT_LOAD(j) do { if (tid < 16) pc4 = *(const f32x4*)(cbp + 64 * (j) + 4 * tid); \
        _Pragma("unroll") for (int k = 0; k < 2; ++k) { const int id = tid + 512 * k; int pos = 64 * (j) + (id >> 4); pos = pos < LTOT ? pos : LTOT - 1; \
        const bf16_t* rp = proj + (size_t)rowof(b, pos) * NWIDE + h * 128 + (id & 15) * 8; \
        pk[k] = *(const u32x4*)(rp + COL_FK); pv[k] = *(const u32x4*)(rp + COL_FV); prk[k] = rkp[pos]; } } while (0)
#define ATT_STORE(bufp) do { if (tid < 16) *(LAS f32x4*)((bufp) + AB_C + 16 * tid) = pc4; _Pragma("unroll") for (int k = 0; k < 2; ++k) { const int id = tid + 512 * k; \
        u32x4 kq; const float rs = prk[k];   \
        kq.x = pk2(bflo(pk[k].x) * rs, bfhi(pk[k].x) * rs); kq.y = pk2(bflo(pk[k].y) * rs, bfhi(pk[k].y) * rs); kq.z = pk2(bflo(pk[k].z) * rs, bfhi(pk[k].z) * rs); kq.w = pk2(bflo(pk[k].w) * rs, bfhi(pk[k].w) * rs); \
        *(LAS u32x4*)((bufp) + AB_K + (id >> 4) * 272 + (id & 15) * 16) = kq; *(LAS u32x4*)((bufp) + AB_V + (id >> 4) * 272 + (id & 15) * 16) = pv[k]; } } while (0)
    u32x4 gl[8];
    { const bf16_t* gsrc = proj + ((size_t)b * SEQ + 256 * qblk + (tid >> 1)) * NWIDE + COL_FG + h * 128 + (tid & 1) * 64;
#pragma unroll
      for (int i = 0; i < 8; ++i) gl[i] = *(const u32x4*)(gsrc + 8 * i); }
    ATT_LOAD(nT - 1);
    const bf16_t* qp = proj + row * NWIDE + COL_FQ + h * 128 + 8 * hh;
    u32x4 qraw[8]; float ss = 0.f;
#pragma unroll
    for (int ks = 0; ks < 8; ++ks) qraw[ks] = *(const u32x4*)(qp + 16 * ks);
    CB();
    { LAS unsigned char* gdst = lds + 2 * AB_SIZE + (tid >> 1) * 264 + (tid & 1) * 128;
#pragma unroll
      for (int i = 0; i < 8; ++i) { LAS u32x2* d2 = (LAS u32x2*)(gdst + 16 * i); d2[0] = (u32x2){gl[i].x, gl[i].y}; d2[1] = (u32x2){gl[i].z, gl[i].w}; } }
    CB();
#pragma unroll
    for (int ks = 0; ks < 8; ++ks) {
#pragma unroll
        for (int e = 0; e < 4; ++e) { const float lo = bflo(qraw[ks][e]), hi = bfhi(qraw[ks][e]); ss += lo * lo + hi * hi; } }
    ss = xhalf_sum(ss);
    const float qsc = rsqrtf(ss * (1.f / HD) + EPSF);
    const LAS float* qw = (const LAS float*)(lds + L_QW);
    bf16x8 Qb[8];
#pragma unroll
    for (int ks = 0; ks < 8; ++ks) { const f32x4 w0 = *(const LAS f32x4*)(qw + 16 * ks + 8 * hh), w1 = *(const LAS f32x4*)(qw + 16 * ks + 8 * hh + 4);
        u32x4 o; o.x = pk2(bflo(qraw[ks].x) * qsc * w0[0], bfhi(qraw[ks].x) * qsc * w0[1]); o.y = pk2(bflo(qraw[ks].y) * qsc * w0[2], bfhi(qraw[ks].y) * qsc * w0[3]);
        o.z = pk2(bflo(qraw[ks].z) * qsc * w1[0], bfhi(qraw[ks].z) * qsc * w1[1]); o.w = pk2(bflo(qraw[ks].w) * qsc * w1[2], bfhi(qraw[ks].w) * qsc * w1[3]);
        Qb[ks] = __builtin_bit_cast(bf16x8, o); }
    f32x16 O[4];
#pragma unroll
    for (int dt = 0; dt < 4; ++dt)
#pragma unroll
        for (int t = 0; t < 16; ++t) O[dt][t] = 0.f;
    float m = -INFINITY, l = 0.f;
    ATT_STORE(lds);
    __syncthreads();
    for (int it = 0; it < nT; ++it) {
        const int j = nT - 1 - it;
        const LAS unsigned char* buf = lds + (it & 1) * AB_SIZE;
        if (it + 1 < nT) ATT_LOAD(j - 1);
#pragma unroll
        for (int stt = 0; stt < 2; ++stt) {
            const int st = 1 - stt;
            const int kb = 64 * j + 32 * st;
            if (kb <= qs + 31) {
                f32x16 s;
#pragma unroll
                for (int t = 0; t < 16; ++t) s[t] = 0.f;
                const LAS unsigned char* kp = buf + AB_K + (32 * st + r) * 272 + 16 * hh;
                bf16x8 kf[4], vf[4];
#pragma unroll
                for (int ks = 0; ks < 4; ++ks) kf[ks] = *(const LAS bf16x8*)(kp + 32 * ks);
                CB();
#pragma unroll
                for (int ks = 0; ks < 4; ++ks) s = MFMA32(kf[ks], Qb[ks], s);
#pragma unroll
                for (int ks = 0; ks < 4; ++ks) kf[ks] = *(const LAS bf16x8*)(kp + 128 + 32 * ks);
                CB();
#pragma unroll
                for (int ks = 0; ks < 4; ++ks) s = MFMA32(kf[ks], Qb[4 + ks], s);
                const LAS unsigned char* vp0 = buf + AB_V + (32 * st + 4 * hh + tq) * 272 + (16 * tblk + 4 * tp) * 2;
#pragma unroll
                for (int dt = 0; dt < 2; ++dt) { const LAS unsigned char* vp = vp0 + 64 * dt; vf[2 * dt] = tr_pair(vp, vp + 8 * 272); vf[2 * dt + 1] = tr_pair(vp + 16 * 272, vp + 24 * 272); }
                CB();
                const bool needmask = (kb + 31 > qs);
                float mx = -INFINITY;
#pragma unroll
                for (int g = 0; g < 4; ++g) { const f32x4 nb4 = -*(const LAS f32x4*)(buf + AB_C + 4 * (32 * st + 8 * g + 4 * hh));
                    if (needmask) {
#pragma unroll
                        for (int e = 0; e < 4; ++e) { float v = s[4 * g + e] + nb4[e]; if (kb + 8 * g + 4 * hh + e > qpos) v = -INFINITY; s[4 * g + e] = v; mx = fmaxf(mx, v); }
                    } else {
#pragma unroll
                        for (int e = 0; e < 4; ++e) { const float v = s[4 * g + e] + nb4[e]; s[4 * g + e] = v; mx = fmaxf(mx, v); }
                    } }
                mx = xhalf_max(mx);
                const float mn = fmaxf(m, mx);
                const float mref = (mn == -INFINITY) ? 0.f : mn;
                const float alpha = __builtin_amdgcn_exp2f(m - mref);
                float ps = 0.f;
#pragma unroll
                for (int t = 0; t < 16; ++t) { const float pv_ = __builtin_amdgcn_exp2f(s[t] - mref); s[t] = pv_; ps += pv_; }
                m = mn;
                if (__builtin_amdgcn_ballot_w64(alpha != 1.f) != 0ull) {
                    l = l * alpha + ps;
#pragma unroll
                    for (int dt = 0; dt < 4; ++dt) O[dt] = O[dt] * alpha;
                } else l += ps;
                const bf16x8 P0 = pack8(s, 0), P1 = pack8(s, 1);
                bf16x8 vg[4];
#pragma unroll
                for (int dt = 0; dt < 2; ++dt) { const LAS unsigned char* vp = vp0 + 64 * (2 + dt); vg[2 * dt] = tr_pair(vp, vp + 8 * 272); vg[2 * dt + 1] = tr_pair(vp + 16 * 272, vp + 24 * 272); }
#pragma unroll
                for (int dt = 0; dt < 2; ++dt) { O[dt] = MFMA32(vf[2 * dt], P0, O[dt]); O[dt] = MFMA32(vf[2 * dt + 1], P1, O[dt]); }
                CB();
#pragma unroll
                for (int dt = 0; dt < 2; ++dt) { O[2 + dt] = MFMA32(vg[2 * dt], P0, O[2 + dt]); O[2 + dt] = MFMA32(vg[2 * dt + 1], P1, O[2 + dt]); }
            }
        }
        if (it + 1 < nT) { LAS unsigned char* nb = lds + ((it + 1) & 1) * AB_SIZE; ATT_STORE(nb); }
        __syncthreads();
    }
#undef ATT_LOAD
#undef ATT_STORE
    l = xhalf_sum(l);
    const float inv = __builtin_amdgcn_rcpf(l);
    bf16_t* mp = merged + row * DM + 1024 + h * 128 + 4 * hh;
    const LAS unsigned char* gp = lds + 2 * AB_SIZE + (32 * wid + r) * 264 + 8 * hh;
    u32x2 gzs[16];
#pragma unroll
    for (int i = 0; i < 16; ++i) gzs[i] = *(const LAS u32x2*)(gp + 64 * (i >> 2) + 16 * (i & 3));
#pragma unroll
    for (int dt = 0; dt < 4; ++dt)
#pragma unroll
        for (int g = 0; g < 4; ++g) { const u32x2 gz = gzs[4 * dt + g];
            u32x2 o; o[0] = pk2(O[dt][4 * g] * inv * bflo(gz[0]), O[dt][4 * g + 1] * inv * bfhi(gz[0]));
            o[1] = pk2(O[dt][4 * g + 2] * inv * bflo(gz[1]), O[dt][4 * g + 3] * inv * bfhi(gz[1]));
            *(u32x2*)(mp + 32 * dt + 8 * g) = o; }
}
DI void phase3(const Params& p, LAS unsigned char* lds, int tid, int wid, int lane, int rep) {
    LAS int* stask = (LAS int*)(lds + LDS_BYTES - 16);
    unsigned* ctr = (unsigned*)(p.ws + WS_CTR) + rep;
    if (tid < 128) ((LAS float*)(lds + L_QW))[tid] = p.fq_w[tid] * p.fk_w[tid] * (0.08838834764831845f * LOG2E);
    if (tid == 0) stask[0] = (int)atomicAdd(ctr, 1u);
    __syncthreads();
    int t = stask[0];
    __syncthreads();
    while (t < 64 + 512) {
        asm volatile("" : "+v"(tid)); wid = __builtin_amdgcn_readfirstlane(tid >> 6); lane = tid & 63;
        if (t < 64) gdn_scan_task(p, lds, t, tid, wid, lane);
        else attn_task(p, lds, t - 64, tid, wid, lane);
        if (tid == 0) stask[0] = (int)atomicAdd(ctr, 1u);
        __syncthreads();
        t = stask[0];
        __syncthreads();
    }
}
DI void phase5(const Params& p, int gw, int ngw, int lane) {
    const bf16_t* ob = (const bf16_t*)(p.ws + WS_OUT);
    f32x4 w[8];
#pragma unroll
    for (int j = 0; j < 8; ++j) w[j] = ((const f32x4*)p.post_w)[lane + 64 * j];
    for (int row = gw; row < MR; row += ngw) {
        const u32x2* src = (const u32x2*)(ob + (size_t)row * DM); const f32x4* xs = (const f32x4*)(p.x + (size_t)row * DM);
        u32x2 vb[8]; f32x4 xv[8]; float ss = 0.f;
#pragma unroll
        for (int j = 0; j < 8; ++j) { vb[j] = __builtin_nontemporal_load(src + lane + 64 * j); xv[j] = __builtin_nontemporal_load(xs + lane + 64 * j); }
        CB();
        f32x4 v[8];
#pragma unroll
        for (int j = 0; j < 8; ++j) { v[j] = (f32x4){bflo(vb[j][0]), bfhi(vb[j][0]), bflo(vb[j][1]), bfhi(vb[j][1])}; ss += v[j][0] * v[j][0] + v[j][1] * v[j][1] + v[j][2] * v[j][2] + v[j][3] * v[j][3]; }
        ss = wave_sum(ss);
        const float rstd = rsqrtf(ss * (1.f / DM) + EPSF);
#pragma unroll
        for (int j = 0; j < 8; ++j) __builtin_nontemporal_store(xv[j] + v[j] * rstd * w[j], (f32x4*)(p.out + (size_t)row * DM) + lane + 64 * j);
    }
}

#define XB_TMO      128
#define XB_XCNT(j)  (256  + 64 * (j))
#define XB_XSUB(j)  (1280 + 64 * (j))
#define XB_XGEN(j)  (2304 + 64 * (j))
#define XB_TOP      3328
#define XB_TOPGEN   3392
#define XCD_BAR_WORDS 3456
#define XB_SPIN_CAP (1u << 18)

__device__ __forceinline__ unsigned xb_ld(unsigned* p)              { return __hip_atomic_load(p, __ATOMIC_RELAXED, __HIP_MEMORY_SCOPE_AGENT); }
__device__ __forceinline__ unsigned xb_add(unsigned* p, unsigned v) { return __hip_atomic_fetch_add(p, v, __ATOMIC_RELAXED, __HIP_MEMORY_SCOPE_AGENT); }
__device__ __forceinline__ unsigned xb_xcc_id() { return (unsigned)__builtin_amdgcn_s_getreg((3 << 11) | 20) & 0xFu; }
#define XB_SPIN(cond, bar) do { unsigned _sp = 0; while (cond) { __builtin_amdgcn_s_sleep(1); \
    if ((++_sp & 255u) == 0u) { if (xb_ld(&(bar)[XB_TMO])) break; if (_sp > XB_SPIN_CAP) { atomicAdd(&(bar)[XB_TMO], 1u); break; } } } } while (0)

struct XcdBarrier {
    unsigned* bar; unsigned x;
    volatile LAS unsigned* st;
};

__device__ __forceinline__ XcdBarrier xcd_barrier_post(unsigned* bar, volatile LAS unsigned* st) {
    XcdBarrier b; b.bar = bar; b.x = xb_xcc_id(); b.st = st;
    if (threadIdx.x == 0) (void)xb_add(&bar[XB_XCNT(b.x)], 1u);
    return b;
}
__device__ __forceinline__ void xcd_barrier_complete(unsigned* bar, unsigned x, unsigned& nloc, unsigned& nx) {
    const unsigned G = gridDim.x * gridDim.y * gridDim.z;
    unsigned sum, cnt, mine, sp = 0u;
    for (;;) {
        sum = 0u; cnt = 0u; mine = 0u;
#pragma unroll
        for (unsigned j = 0; j < 16; ++j) { const unsigned c = xb_ld(&bar[XB_XCNT(j)]); sum += c; cnt += (c > 0u) ? 1u : 0u; mine = (j == x) ? c : mine; }
        if (sum == G) break;
        __builtin_amdgcn_s_sleep(1);
        if ((++sp & 255u) == 0u) { if (xb_ld(&bar[XB_TMO])) break; if (sp > XB_SPIN_CAP) { atomicAdd(&bar[XB_TMO], 1u); break; } }
    }
    nloc = mine > 0u ? mine : 1u; nx = cnt > 0u ? cnt : 1u;
}

__device__ __forceinline__ void xcd_barrier(const XcdBarrier& b) {
    asm volatile("s_waitcnt vmcnt(0)" ::: "memory");
    __syncthreads();
    if (threadIdx.x == 0) {
        unsigned* bar = b.bar;
        __builtin_amdgcn_s_waitcnt(0);
        unsigned nloc = b.st[0], nx = b.st[1];
        if (nloc == 0u) { xcd_barrier_complete(bar, b.x, nloc, nx); b.st[0] = nloc; b.st[1] = nx; }
        const unsigned old = xb_add(&bar[XB_XSUB(b.x)], 1u);
        const unsigned gen = old / nloc;
        if (old + 1u == (gen + 1u) * nloc) {
            __builtin_amdgcn_fence(__ATOMIC_RELEASE, "agent");
            asm volatile("s_waitcnt vmcnt(0)" ::: "memory");
            const unsigned og = xb_add(&bar[XB_TOP], 1u);
            const unsigned tg = og / nx;
            if (og + 1u == (tg + 1u) * nx) xb_add(&bar[XB_TOPGEN], 1u);
            else XB_SPIN(xb_ld(&bar[XB_TOPGEN]) == tg, bar);
            __builtin_amdgcn_fence(__ATOMIC_ACQUIRE, "agent");
            xb_add(&bar[XB_XGEN(b.x)], 1u);
            asm volatile("s_waitcnt vmcnt(0)" ::: "memory");
        } else {
            XB_SPIN(xb_ld(&bar[XB_XGEN(b.x)]) == gen, bar);
            __builtin_amdgcn_fence(__ATOMIC_ACQUIRE, "agent");
            asm volatile("s_waitcnt vmcnt(0)" ::: "memory");
        }
    }
    __syncthreads();
}


DI void grid_barrier(unsigned* ctr, unsigned target) {
    asm volatile("s_waitcnt vmcnt(0) lgkmcnt(0)" ::: "memory");
    __syncthreads();
    if (threadIdx.x == 0) {
        __builtin_amdgcn_fence(__ATOMIC_RELEASE, "agent");
        asm volatile("s_waitcnt vmcnt(0)" ::: "memory");
        __hip_atomic_fetch_add(ctr, 1u, __ATOMIC_RELAXED, __HIP_MEMORY_SCOPE_AGENT);
        while (__hip_atomic_load(ctr, __ATOMIC_RELAXED, __HIP_MEMORY_SCOPE_AGENT) < target) __builtin_amdgcn_s_sleep(2);
        __builtin_amdgcn_fence(__ATOMIC_ACQUIRE, "agent");
        asm volatile("s_waitcnt vmcnt(0)" ::: "memory");
    }
    __syncthreads();
}
__global__ void __launch_bounds__(512, 2) hymba_fwd(Params p) {
    extern __shared__ __attribute__((aligned(16))) unsigned char smem[];
    LAS unsigned char* lds = (LAS unsigned char*)smem;
    cg::grid_group grid = cg::this_grid();
    unsigned* gbar = (unsigned*)(p.ws + WS_BAR);
    volatile LAS unsigned* xst = (volatile LAS unsigned*)(lds + LDS_BYTES - 32);
    if (threadIdx.x == 0) { xst[0] = 0u; xst[1] = 0u; }
    __syncthreads();
    const XcdBarrier xbar = xcd_barrier_post(gbar, xst);
    if (p.ws == nullptr) grid.sync();
    int tid = threadIdx.x, wid, lane;
    const int wid0 = __builtin_amdgcn_readfirstlane((int)threadIdx.x >> 6);
#define RELOAD_IDS() do { tid = threadIdx.x; asm volatile("" : "+v"(tid)); wid = __builtin_amdgcn_readfirstlane(tid >> 6); lane = tid & 63; } while (0)
#define RELOAD_IDS2() do { lane = __builtin_amdgcn_mbcnt_hi(~0u, __builtin_amdgcn_mbcnt_lo(~0u, 0u)); wid = wid0; tid = wid0 * 64 + lane; asm volatile("" : "+v"(tid)); } while (0)
    RELOAD_IDS();
    phase0(p, lds, tid, wid, lane);
    xcd_barrier(xbar);
    for (int rep = 0; rep < REP1; ++rep) { if (rep) grid.sync();
    { pg8::Gemm g; g.A = (const bf16_t*)(p.ws + WS_XN); g.Bt = (const bf16_t*)(p.ws + WS_WINT); g.M = MPAD; g.N = NPAD; g.K = DM;
      pg8::StaticOrder S; S.init(MPAD, NPAD, gridDim.x, blockIdx.x);
      EpiProj E; E.P = (bf16_t*)(p.ws + WS_PROJ); E.narrow = (float*)(p.ws + WS_NARROW);
      pg8::gemm_phase<EpiProj, pg8::StaticOrder, true, true>(lds, g, S, E, tid); } }
    xcd_barrier(xbar);
    for (int rep = 0; rep < REP2; ++rep) { if (rep) grid.sync();
    RELOAD_IDS();
    phase2(p, lds, tid, wid, lane); }
    xcd_barrier(xbar);
    for (int rep = 0; rep < REP3; ++rep) { if (rep) grid.sync();
    RELOAD_IDS();
    phase3(p, lds, tid, wid, lane, rep); }
    xcd_barrier(xbar);
    { pg8::Gemm g; g.A = (const bf16_t*)((const unsigned char*)p.out + DO_MERGED); g.Bt = (const bf16_t*)(p.ws + WS_WOUTT); g.M = MR; g.N = DM; g.K = DM;
      pg8::StaticOrder S; S.init(MR, DM, gridDim.x, blockIdx.x);
      EpiOut E; E.C = (bf16_t*)(p.ws + WS_OUT);
      RELOAD_IDS2();
      pg8::gemm_phase<EpiOut, pg8::StaticOrder, true, true>(lds, g, S, E, tid); }
    xcd_barrier(xbar);
    RELOAD_IDS2();
    phase5(p, blockIdx.x * 8 + wid, gridDim.x * 8, lane);
}

extern "C" void kernel_launch(void* const* d_in, const int* in_sizes, int n_in, void* d_out, int out_size, void* d_ws, size_t ws_size, hipStream_t stream) {
    static int grid_blocks = 0;
    if (!grid_blocks) {
        int dev = 0, cus = 0, per_cu = 0;
        hipGetDevice(&dev);
        hipDeviceGetAttribute(&cus, hipDeviceAttributeMultiprocessorCount, dev);
        hipFuncSetAttribute((const void*)hymba_fwd, hipFuncAttributeMaxDynamicSharedMemorySize, LDS_BYTES);
        hipOccupancyMaxActiveBlocksPerMultiprocessor(&per_cu, (const void*)hymba_fwd, 512, LDS_BYTES);
        if (per_cu < 1) per_cu = 1;
        grid_blocks = cus;
        if (ws_size < WS_END) fprintf(stderr, "kernel_launch: workspace too small: %zu < %zu\n", ws_size, (size_t)WS_END);
    }
    Params p{};
    p.x = (const float*)d_in[0]; p.meta = (const float*)d_in[1]; p.pre_w = (const float*)d_in[2]; p.w_in = (const float*)d_in[3]; p.conv_w = (const float*)d_in[4];
    p.a_log = (const float*)d_in[5]; p.dt_bias = (const float*)d_in[6]; p.gdn_norm_w = (const float*)d_in[7]; p.fq_w = (const float*)d_in[8]; p.fk_w = (const float*)d_in[9];
    p.f_bias = (const float*)d_in[10]; p.w_out = (const float*)d_in[11]; p.post_w = (const float*)d_in[12];
    p.out = (float*)d_out; p.ws = (unsigned char*)d_ws;
    (void)hipMemsetAsync((unsigned char*)d_ws + WS_BAR, 0, 16384, stream);
    void* args[] = {&p};
    hipError_t e = hipLaunchCooperativeKernel((const void*)hymba_fwd, dim3(grid_blocks), dim3(512), args, LDS_BYTES, stream);
    if (e != hipSuccess) fprintf(stderr, "cooperative launch failed: %s (grid %d)\n", hipGetErrorString(e), grid_blocks);
}
```

```cpp
#include <hip/hip_runtime.h>
#include <hip/hip_cooperative_groups.h>
#include <cstdio>
#include <type_traits>
namespace cg = cooperative_groups;

#define DI __device__ __forceinline__
#define LAS __attribute__((address_space(3)))
typedef float f32x16 __attribute__((ext_vector_type(16)));
typedef short s16x4 __attribute__((ext_vector_type(4)));
typedef unsigned u32x2 __attribute__((ext_vector_type(2)));

namespace pg8 {
#define PG8_LAS __attribute__((address_space(3)))
typedef unsigned short bf16_t;
typedef short bf16x8 __attribute__((ext_vector_type(8)));
typedef float f32x4 __attribute__((ext_vector_type(4)));
typedef unsigned u32x4 __attribute__((ext_vector_type(4)));
constexpr int BM = 256, BK = 64, HALF = 128, HTB = HALF * BK * 2  , STAGE_BYTES = 8 * HTB, NXCD = 8, WGM = 8;

__host__ __device__ __forceinline__ int lds_byte(int r, int c) { const int st = (r >> 4) * 2 + (c >> 5), rr = r & 15, cc = c & 31, ob = rr * 64 + cc * 2; return st * 1024 + (ob ^ (((ob >> 9) & 1) << 5)); }
__host__ __device__ __forceinline__ void stage_rc(int b, int& R, int& C) { const int st = b / 1024, sb = b % 1024, swz = sb ^ (((sb >> 9) & 1) << 5); R = (st >> 1) * 16 + swz / 64; C = (st & 1) * 32 + (swz % 64) / 2; }
__host__ __device__ __forceinline__ int perm32(int rho) { const int n = rho >> 4, i = rho & 15; return 8 * (i >> 2) + 4 * n + (i & 3); }

struct Unit { int pm, pn; };
struct Gemm { const bf16_t* A; const bf16_t* Bt; int M, N, K; };

struct StaticOrder {
    int nM, nN, nwg, G, c;
    __host__ __device__ void init(int M, int N, int G_, int c_) { nM = M / BM; nN = N / BM; nwg = nM * nN; G = G_; c = c_; }
    __host__ __device__ bool next(int i, Unit& u) const {
        const long L = (long)i * G + c; if (L >= nwg) return false;
        int wgid = (int)L; { const int q = nwg / NXCD, r = nwg % NXCD, xcd = wgid % NXCD, off = wgid / NXCD; wgid = (xcd < r ? xcd * (q + 1) : r * (q + 1) + (xcd - r) * q) + off; }
        const int nig = WGM * nN, gid = wgid / nig, fm = gid * WGM, gsz = (nM - fm) < WGM ? (nM - fm) : WGM;
        u.pm = fm + ((wgid % nig) % gsz); u.pn = (wgid % nig) / gsz; return true;
    }
    __device__ __forceinline__ void a_ready(const Unit&) const {}
    __device__ __forceinline__ void done(const Unit&) const {}
};
typedef unsigned u32x4 __attribute__((ext_vector_type(4)));
template <class Epi, class Sched, bool ALIGN_EPI = false, bool SP2 = false>
__device__ __forceinline__ void gemm_phase(PG8_LAS unsigned char* lds, const Gemm g, const Sched& S, const Epi& E, const int tid) {
    const int wid = __builtin_amdgcn_readfirstlane(tid >> 6), lane = tid & 63, wr = wid >> 2, wc = wid & 3, fr = lane & 15, fq = lane >> 4;
    const int K = g.K, nt = K / BK;
    unsigned voffA[2], voffB[2];
#pragma unroll
    for (int i = 0; i < 2; ++i) { int R, C; stage_rc(tid * 16 + i * 8192, R, C); const int Rb = Epi::PERM ? ((R & ~31) + perm32(R & 31)) : R;
        voffA[i] = (unsigned)(R * K + C) * 2u; voffB[i] = (unsigned)(Rb * K + C) * 2u; }
    const size_t kstep = (size_t)(BK * 2);
    const size_t hstep = (size_t)HALF * K * 2;
    const size_t tstep = 2 * hstep;
    const unsigned ldsw = (unsigned)wid * 1024u;
    const int aoff = lds_byte(wr * 64 + fr, fq * 8), boff = lds_byte(wc * 32 + fr, fq * 8);
#define PG8_SA(b, h) (((b) * 2 + (h)) * HTB)
#define PG8_SB(b, h) ((4 + (b) * 2 + (h)) * HTB)
#define PG8_STAGE(bufoff, gbase, voff) do { _Pragma("unroll") for (int _i = 0; _i < 2; ++_i) \
        __builtin_amdgcn_global_load_lds((const unsigned*)((const char*)(gbase) + (voff)[_i]), (PG8_LAS unsigned*)(lds + (bufoff) + ldsw + _i * 8192), 16, 0, 0); } while (0)
#define PG8_LDA(dst, b, h) do { _Pragma("unroll") for (int m = 0; m < 4; ++m) _Pragma("unroll") for (int k = 0; k < 2; ++k) dst[m][k] = *(const PG8_LAS bf16x8*)(lds + PG8_SA(b, h) + aoff + m * 2048 + k * 1024); } while (0)
#define PG8_LDB(dst, b, h) do { _Pragma("unroll") for (int n = 0; n < 2; ++n) _Pragma("unroll") for (int k = 0; k < 2; ++k) dst[n][k] = *(const PG8_LAS bf16x8*)(lds + PG8_SB(b, h) + boff + n * 2048 + k * 1024); } while (0)
#define PG8_MMA(ai, bj, At, Bt) do { __builtin_amdgcn_s_setprio(1); _Pragma("unroll") for (int m = 0; m < 4; ++m) _Pragma("unroll") for (int n = 0; n < 2; ++n) _Pragma("unroll") for (int k = 0; k < 2; ++k) \
        acc[ai][bj][m][n] = __builtin_amdgcn_mfma_f32_16x16x32_bf16(Bt[n][k], At[m][k], acc[ai][bj][m][n], 0, 0, 0); __builtin_amdgcn_s_setprio(0); } while (0)
#define PG8_WAIT_V(n) asm volatile("s_waitcnt vmcnt(" #n ")" ::: "memory")
#define PG8_WAIT_L(n) asm volatile("s_waitcnt lgkmcnt(" #n ")" ::: "memory")
#define PG8_BAR __builtin_amdgcn_s_barrier()
#define PG8_SCHED __builtin_amdgcn_sched_barrier(0)
    Unit cur, nxt; int ui = 0;
    if (!S.next(0, cur)) return;
    f32x4 acc[2][2][4][2];
#pragma unroll
    for (int a = 0; a < 2; ++a)
#pragma unroll
        for (int b = 0; b < 2; ++b)
#pragma unroll
            for (int m = 0; m < 4; ++m)
#pragma unroll
                for (int n = 0; n < 2; ++n) acc[a][b][m][n] = (f32x4){0.f, 0.f, 0.f, 0.f};
    bf16x8 At[4][2], B0[2][2], B1[2][2];
    const char* cA = (const char*)g.A + (size_t)cur.pm * tstep; const char* cB = (const char*)g.Bt + (size_t)cur.pn * tstep;
    S.a_ready(cur);
    if constexpr (SP2) {
        PG8_STAGE(PG8_SB(0, 0), cB, voffB); PG8_STAGE(PG8_SB(0, 1), cB + hstep, voffB); PG8_STAGE(PG8_SA(0, 0), cA, voffA); PG8_STAGE(PG8_SA(0, 1), cA + hstep, voffA);
        if (wr == 1) PG8_BAR;
        PG8_WAIT_V(2); PG8_BAR;
        PG8_STAGE(PG8_SB(1, 0), cB + kstep, voffB); PG8_STAGE(PG8_SA(1, 0), cA + kstep, voffA); PG8_STAGE(PG8_SB(1, 1), cB + hstep + kstep, voffB);
        PG8_WAIT_V(6); PG8_BAR;
    } else {
        PG8_STAGE(PG8_SB(0, 0), cB, voffB); PG8_STAGE(PG8_SA(0, 0), cA, voffA); PG8_STAGE(PG8_SB(0, 1), cB + hstep, voffB); PG8_STAGE(PG8_SA(0, 1), cA + hstep, voffA);
        if (wr == 1) PG8_BAR;
        PG8_WAIT_V(4); PG8_BAR;
        PG8_STAGE(PG8_SB(1, 0), cB + kstep, voffB); PG8_STAGE(PG8_SA(1, 0), cA + kstep, voffA); PG8_STAGE(PG8_SB(1, 1), cB + hstep + kstep, voffB);
        PG8_WAIT_V(6); PG8_BAR;
    }
    for (;;) {
        const bool has_next = S.next(ui + 1, nxt);
        const char* nA = has_next ? (const char*)g.A + (size_t)nxt.pm * tstep : cA; const char* nB = has_next ? (const char*)g.Bt + (size_t)nxt.pn * tstep : cB;
        for (int t = 0; t < nt; t += 2) {
            const bool last = (t == nt - 2);
            const char* a1 = cA + (size_t)(t + 1) * kstep;
            const char* a2 = last ? nA : cA + (size_t)(t + 2) * kstep; const char* b2 = last ? nB : cB + (size_t)(t + 2) * kstep;
            const char* a3 = a2 + kstep; const char* b3 = b2 + kstep;
            if (last && has_next) S.a_ready(nxt);
            if constexpr (SP2) {
            PG8_LDB(B0, 0, 0); PG8_LDB(B1, 0, 1); PG8_SCHED; PG8_LDA(At, 0, 0); PG8_STAGE(PG8_SA(1, 1), a1 + hstep, voffA);
            PG8_WAIT_V(8); PG8_WAIT_L(0); PG8_BAR; PG8_MMA(0, 0, At, B0); PG8_MMA(0, 1, At, B1); PG8_BAR; PG8_SCHED;
            PG8_LDA(At, 0, 1); PG8_STAGE(PG8_SB(0, 0), b2, voffB); PG8_STAGE(PG8_SB(0, 1), b2 + hstep, voffB); PG8_STAGE(PG8_SA(0, 0), a2, voffA);
            PG8_WAIT_V(8); PG8_WAIT_L(0); PG8_BAR; PG8_MMA(1, 0, At, B0); PG8_MMA(1, 1, At, B1); PG8_BAR; PG8_SCHED;
            PG8_LDB(B0, 1, 0); PG8_LDB(B1, 1, 1); PG8_SCHED; PG8_LDA(At, 1, 0); PG8_STAGE(PG8_SA(0, 1), a2 + hstep, voffA);
            PG8_WAIT_V(8); PG8_WAIT_L(0); PG8_BAR; PG8_MMA(0, 0, At, B0); PG8_MMA(0, 1, At, B1); PG8_BAR; PG8_SCHED;
            PG8_LDA(At, 1, 1); PG8_STAGE(PG8_SB(1, 0), b3, voffB); PG8_STAGE(PG8_SB(1, 1), b3 + hstep, voffB); PG8_STAGE(PG8_SA(1, 0), a3, voffA);
            PG8_WAIT_V(8); PG8_WAIT_L(0); PG8_BAR; PG8_MMA(1, 0, At, B0); PG8_MMA(1, 1, At, B1); PG8_BAR; PG8_SCHED;
            } else {
            PG8_LDB(B0, 0, 0); PG8_SCHED; PG8_LDA(At, 0, 0); PG8_STAGE(PG8_SA(1, 1), a1 + hstep, voffA);
            PG8_WAIT_L(8); PG8_BAR; PG8_WAIT_L(0); PG8_MMA(0, 0, At, B0); PG8_BAR; PG8_SCHED;
            PG8_LDB(B1, 0, 1); PG8_STAGE(PG8_SB(0, 0), b2, voffB);
            PG8_BAR; PG8_WAIT_L(0); PG8_MMA(0, 1, At, B1); PG8_BAR;
            PG8_LDA(At, 0, 1); PG8_STAGE(PG8_SA(0, 0), a2, voffA);
            PG8_BAR; PG8_WAIT_L(0); PG8_MMA(1, 0, At, B0); PG8_BAR; PG8_SCHED;
            PG8_STAGE(PG8_SB(0, 1), b2 + hstep, voffB);
            PG8_WAIT_V(6); PG8_BAR; PG8_MMA(1, 1, At, B1); PG8_BAR;
            PG8_LDB(B0, 1, 0); PG8_SCHED; PG8_LDA(At, 1, 0); PG8_STAGE(PG8_SA(0, 1), a2 + hstep, voffA);
            PG8_WAIT_L(8); PG8_BAR; PG8_WAIT_L(0); PG8_MMA(0, 0, At, B0); PG8_BAR; PG8_SCHED;
            PG8_LDB(B1, 1, 1); PG8_STAGE(PG8_SB(1, 0), b3, voffB);
            PG8_BAR; PG8_WAIT_L(0); PG8_MMA(0, 1, At, B1); PG8_BAR;
            PG8_LDA(At, 1, 1); PG8_STAGE(PG8_SA(1, 0), a3, voffA);
            PG8_BAR; PG8_WAIT_L(0); PG8_MMA(1, 0, At, B0); PG8_BAR; PG8_SCHED;
            PG8_STAGE(PG8_SB(1, 1), b3 + hstep, voffB);
            PG8_WAIT_V(6); PG8_BAR; PG8_MMA(1, 1, At, B1); PG8_BAR;
            }
        }
        if constexpr (ALIGN_EPI) { if (wr == 0) PG8_BAR; }
        if constexpr (!Epi::AFTER_DRAIN) { E(acc, cur, wr, wc, fr, fq); S.done(cur); }
        if (!has_next) break;
#pragma unroll
        for (int a = 0; a < 2; ++a)
#pragma unroll
            for (int b = 0; b < 2; ++b)
#pragma unroll
                for (int m = 0; m < 4; ++m)
#pragma unroll
                    for (int n = 0; n < 2; ++n) acc[a][b][m][n] = (f32x4){0.f, 0.f, 0.f, 0.f};
        cur = nxt; cA = nA; cB = nB; ++ui;
        if constexpr (ALIGN_EPI) { if (wr == 1) PG8_BAR; }
    }
    PG8_WAIT_V(0);
    if constexpr (!ALIGN_EPI) { if (wr == 0) PG8_BAR; }
    PG8_BAR;
    if constexpr (Epi::AFTER_DRAIN) { E.fused(acc, cur, wr, wc, fr, fq, lds, wid, lane); S.done(cur); }
#undef PG8_SA
#undef PG8_SB
#undef PG8_STAGE
#undef PG8_LDA
#undef PG8_LDB
#undef PG8_MMA
#undef PG8_WAIT_V
#undef PG8_WAIT_L
#undef PG8_BAR
#undef PG8_SCHED
}
}
using pg8::bf16_t; using pg8::bf16x8; using pg8::f32x4; using pg8::u32x4;

constexpr int NB = 8, SEQ = 2048, DM = 2048, NMETA = 16, LTOT = 2064, HD = 128, NH = 8;
constexpr int MR = NB * SEQ;
constexpr int MPAD = 16640;
constexpr int NWIDE = 8192, NPAD = 8448;
constexpr int NCH = 33;
constexpr int LP = 2112;
constexpr int COL_GQ = 0, COL_GK = 1024, COL_GV = 2048, COL_GZ = 3072, COL_FQ = 4096, COL_FK = 5120, COL_FV = 6144, COL_FG = 7168;
constexpr float EPSF = 1e-6f;
constexpr float LOG2E = 1.4426950408889634f;

constexpr size_t MiB = 1024 * 1024;
constexpr size_t WS_XN = 0;
constexpr size_t WS_WINT = 65 * MiB;
constexpr size_t WS_U = 0;
constexpr size_t WS_W = 33 * MiB;
constexpr size_t WS_WOUTT = 104 * MiB;
constexpr size_t WS_PROJ = 112 * MiB;
constexpr size_t WS_OUT = 112 * MiB;
constexpr size_t WS_NARROW = 372 * MiB;
constexpr size_t WS_RK = 375 * MiB;
constexpr size_t WS_FK = 376 * MiB;
constexpr size_t WS_FVT = 408 * MiB;
constexpr size_t WS_KDT = 441 * MiB;
constexpr size_t WS_C2 = 474 * MiB;
constexpr size_t WS_DECAY = 475 * MiB;
constexpr size_t WS_CTR = 476 * MiB;
constexpr size_t WS_BAR = 476 * MiB + 65536;
constexpr size_t WS_END = 477 * MiB;
constexpr size_t DO_MERGED = 0, DO_QD = 64 * MiB, DO_AQK = 97 * MiB;
#ifndef REP1
#define REP1 1
#endif
#ifndef REP2
#define REP2 1
#endif
#ifndef REP3
#define REP3 1
#endif
constexpr int LDS_BYTES = 156160;
constexpr int L_QW = 155136;

struct Params {
    const float* x; const float* meta; const float* pre_w; const float* w_in; const float* conv_w; const float* a_log; const float* dt_bias;
    const float* gdn_norm_w; const float* fq_w; const float* fk_w; const float* f_bias; const float* w_out; const float* post_w;
    float* out; unsigned char* ws;
};

typedef __bf16 bf16n2 __attribute__((ext_vector_type(2)));
typedef float f32x2 __attribute__((ext_vector_type(2)));
DI unsigned pk2(float lo, float hi) { const f32x2 v = {lo, hi}; return __builtin_bit_cast(unsigned, __builtin_convertvector(v, bf16n2)); }
DI unsigned f2bf(float x) { return pk2(x, 0.f) & 0xffffu; }
DI float bflo(unsigned u) { return __uint_as_float(u << 16); }
DI float bfhi(unsigned u) { return __uint_as_float(u & 0xffff0000u); }
DI float bf2f(bf16_t b) { return __uint_as_float(((unsigned)b) << 16); }
DI float wave_sum(float v);
template <int CTRL> DI float dppf(float x) { return __int_as_float(__builtin_amdgcn_update_dpp(0, __float_as_int(x), CTRL, 0xf, 0xf, true)); }
DI float sum4_dpp(float x) { x += dppf<0xB1>(x); x += dppf<0x4E>(x); return x; }
DI float sum16_dpp(float x) { x = sum4_dpp(x); x += dppf<0x141>(x); x += dppf<0x140>(x); return x; }
DI float xhalf_max(float x) { const u32x2 rr = __builtin_amdgcn_permlane32_swap(__float_as_uint(x), __float_as_uint(x), false, false); return fmaxf(__uint_as_float(rr[0]), __uint_as_float(rr[1])); }
DI float xhalf_sum(float x) { const u32x2 rr = __builtin_amdgcn_permlane32_swap(__float_as_uint(x), __float_as_uint(x), false, false); return __uint_as_float(rr[0]) + __uint_as_float(rr[1]); }
template <int CTRL, int RM, bool BC> DI float dppx(float x) { return __int_as_float(__builtin_amdgcn_update_dpp(0, __float_as_int(x), CTRL, RM, 0xf, BC)); }
DI float scan64_dpp(float v) {
    v += dppx<0x111, 0xf, true>(v); v += dppx<0x112, 0xf, true>(v); v += dppx<0x114, 0xf, true>(v); v += dppx<0x118, 0xf, true>(v);
    v += dppx<0x142, 0xa, false>(v); v += dppx<0x143, 0xc, false>(v); return v; }
DI float lane_bcast(float x, int l) { return __int_as_float(__builtin_amdgcn_readlane(__float_as_int(x), l)); }
DI float wave_sum(float v) { v = sum16_dpp(v); return (lane_bcast(v, 0) + lane_bcast(v, 16)) + (lane_bcast(v, 32) + lane_bcast(v, 48)); }
DI float sigmoidf_(float x) { return __builtin_amdgcn_rcpf(1.f + __expf(-x)); }
DI float siluf_(float x) { return x * __builtin_amdgcn_rcpf(1.f + __expf(-x)); }
DI float softplusf_(float x) { return x > 20.f ? x : __logf(1.f + __expf(x)); }
DI int rowof(int b, int p) { return p < NMETA ? MR + p : b * SEQ + (p - NMETA); }
DI int crow(int t, int hh) { return (t & 3) + 8 * (t >> 2) + 4 * hh; }
DI bf16x8 pack8(const f32x16& x, int s) {
    u32x4 p;
    p[0] = pk2(x[8 * s + 0], x[8 * s + 1]); p[1] = pk2(x[8 * s + 2], x[8 * s + 3]); p[2] = pk2(x[8 * s + 4], x[8 * s + 5]); p[3] = pk2(x[8 * s + 6], x[8 * s + 7]);
    return __builtin_bit_cast(bf16x8, p);
}
#define LDS_BARRIER() do { asm volatile("s_waitcnt lgkmcnt(0)" ::: "memory"); __builtin_amdgcn_s_barrier(); asm volatile("" ::: "memory"); } while (0)
#define CB() asm volatile("" ::: "memory")
#define MFMA32(a, b, c) __builtin_amdgcn_mfma_f32_32x32x16_bf16((a), (b), (c), 0, 0, 0)
DI bf16x8 ldfrag_perm(const bf16_t* rowp, int k0, int hh) {
    const u32x2 a = *(const u32x2*)(rowp + k0 + 4 * hh), b = *(const u32x2*)(rowp + k0 + 8 + 4 * hh);
    u32x4 p; p[0] = a[0]; p[1] = a[1]; p[2] = b[0]; p[3] = b[1];
    return __builtin_bit_cast(bf16x8, p);
}
struct EpiProj {
    static constexpr bool PERM = true, AFTER_DRAIN = false;
    bf16_t* P; float* narrow;
    DI void operator()(const f32x4 (&acc)[2][2][4][2], const pg8::Unit& u, int wr, int wc, int fr, int fq) const {
        const int row0 = u.pm * 256 + wr * 64 + fr;
        if (u.pn < 32) {
            const int col0 = u.pn * 256 + wc * 32 + 8 * fq;
            const bool gate = (u.pn >= 12 && u.pn < 16) || (u.pn >= 28);
#pragma unroll
            for (int ai = 0; ai < 2; ++ai)
#pragma unroll
                for (int m = 0; m < 4; ++m) { bf16_t* rowp = P + (size_t)(row0 + ai * 128 + m * 16) * NWIDE + col0;
#pragma unroll
                    for (int bj = 0; bj < 2; ++bj) { f32x4 v0 = acc[ai][bj][m][0], v1 = acc[ai][bj][m][1];
                        if (gate) {
#pragma unroll
                            for (int e = 0; e < 4; ++e) { v0[e] = siluf_(v0[e]); v1[e] = siluf_(v1[e]); } }
                        u32x4 w; w.x = pk2(v0[0], v0[1]); w.y = pk2(v0[2], v0[3]); w.z = pk2(v1[0], v1[1]); w.w = pk2(v1[2], v1[3]);
                        *(u32x4*)(rowp + bj * 128) = w; } }
        } else if (wc == 0) {
#pragma unroll
            for (int ai = 0; ai < 2; ++ai)
#pragma unroll
                for (int m = 0; m < 4; ++m) { float* rp = narrow + (size_t)(row0 + ai * 128 + m * 16) * 32 + 8 * fq;
                    *(f32x4*)rp = acc[ai][0][m][0]; *(f32x4*)(rp + 4) = acc[ai][0][m][1]; }
        }
    }
};
struct EpiOut {
    static constexpr bool PERM = true, AFTER_DRAIN = false;
    bf16_t* C;
    DI void operator()(const f32x4 (&acc)[2][2][4][2], const pg8::Unit& u, int wr, int wc, int fr, int fq) const {
        const int row0 = u.pm * 256 + wr * 64 + fr, col0 = u.pn * 256 + wc * 32 + 8 * fq;
#pragma unroll
        for (int ai = 0; ai < 2; ++ai)
#pragma unroll
            for (int m = 0; m < 4; ++m) { bf16_t* rowp = C + (size_t)(row0 + ai * 128 + m * 16) * DM + col0;
#pragma unroll
                for (int bj = 0; bj < 2; ++bj) { const f32x4 v0 = acc[ai][bj][m][0], v1 = acc[ai][bj][m][1];
                    u32x4 w; w.x = pk2(v0[0], v0[1]); w.y = pk2(v0[2], v0[3]); w.z = pk2(v1[0], v1[1]); w.w = pk2(v1[2], v1[3]);
                    *(u32x4*)(rowp + bj * 128) = w; } }
    }
};

DI void p0_rmsnorm_rows(const Params& p, int gw, int ngw, int lane) {
    bf16_t* xn = (bf16_t*)(p.ws + WS_XN);
    f32x4 w[8];
#pragma unroll
    for (int j = 0; j < 8; ++j) w[j] = ((const f32x4*)p.pre_w)[lane + 64 * j];
    f32x4 v[8], vnx[8];
    int row = gw;
    if (row < MR + NMETA) { const float* src = row < MR ? p.x + (size_t)row * DM : p.meta + (size_t)(row - MR) * DM;
#pragma unroll
        for (int j = 0; j < 8; ++j) v[j] = __builtin_nontemporal_load((const f32x4*)src + lane + 64 * j); }
    for (; row < MR + NMETA; row += ngw) {
        const int nrow = row + ngw;
        if (nrow < MR + NMETA) { const float* src = nrow < MR ? p.x + (size_t)nrow * DM : p.meta + (size_t)(nrow - MR) * DM;
#pragma unroll
            for (int j = 0; j < 8; ++j) vnx[j] = __builtin_nontemporal_load((const f32x4*)src + lane + 64 * j); }
        float ss = 0.f;
#pragma unroll
        for (int j = 0; j < 8; ++j) ss += v[j][0] * v[j][0] + v[j][1] * v[j][1] + v[j][2] * v[j][2] + v[j][3] * v[j][3];
        ss = wave_sum(ss);
        const float rstd = rsqrtf(ss * (1.f / DM) + EPSF);
#pragma unroll
        for (int j = 0; j < 8; ++j) {
            u32x2 o; o[0] = pk2(v[j][0] * rstd * w[j][0], v[j][1] * rstd * w[j][1]); o[1] = pk2(v[j][2] * rstd * w[j][2], v[j][3] * rstd * w[j][3]);
            *(u32x2*)(xn + (size_t)row * DM + 4 * (lane + 64 * j)) = o; }
#pragma unroll
        for (int j = 0; j < 8; ++j) v[j] = vnx[j];
    }
}
DI int remap_in_col(int c) {
    if (c < 4096) return c;
    if (c < 4112) return NWIDE + (c - 4096);
    if (c < 8208) return c - 16;
    return NWIDE + 16 + (c - 8208);
}
DI void p0_transpose_item(const float* src, int ncols, int k0, int n0, bf16_t* dst, bool remap, LAS float* scr, int lane) {
    const int col = n0 + (lane & 31);
    float v[32];
#pragma unroll
    for (int i = 0; i < 32; ++i) { const int kk = 2 * i + (lane >> 5); v[i] = col < ncols ? __builtin_nontemporal_load(src + (size_t)(k0 + kk) * ncols + col) : 0.f; }
#pragma unroll
    for (int i = 0; i < 32; ++i) { const int kk = 2 * i + (lane >> 5); scr[kk * 33 + (lane & 31)] = v[i]; }
    CB();
    const int c = lane & 7;
#pragma unroll
    for (int j = 0; j < 4; ++j) { const int n = (lane >> 3) + 8 * j, cc = n0 + n; const LAS float* t = scr + (8 * c) * 33 + n;
        u32x4 o; o.x = pk2(t[0], t[33]); o.y = pk2(t[2 * 33], t[3 * 33]); o.z = pk2(t[4 * 33], t[5 * 33]); o.w = pk2(t[6 * 33], t[7 * 33]);
        if (cc < ncols) *(u32x4*)(dst + (size_t)(remap ? remap_in_col(cc) : cc) * 2048 + k0 + 8 * c) = o; }
    CB();
}
DI void phase0(const Params& p, LAS unsigned char* lds, int tid, int wid, int lane) {
    if (blockIdx.x == 0 && tid < 64) ((unsigned*)(p.ws + WS_CTR))[tid] = 0u;
    const int gw = blockIdx.x * 8 + wid, ngw = gridDim.x * 8;
    p0_rmsnorm_rows(p, gw, ngw, lane);
    constexpr int NB_IN = (8216 + 31) / 32;
    constexpr int I_IN = 32 * NB_IN, I_OUT = 32 * 64;
    LAS float* scr = (LAS float*)lds + wid * (64 * 33);
    for (int it = gw; it < I_IN + I_OUT; it += ngw) {
        if (it < I_IN) p0_transpose_item(p.w_in, 8216, 64 * (it / NB_IN), 32 * (it % NB_IN), (bf16_t*)(p.ws + WS_WINT), true, scr, lane);
        else { const int u = it - I_IN; p0_transpose_item(p.w_out, 2048, 64 * (u >> 6), 32 * (u & 63), (bf16_t*)(p.ws + WS_WOUTT), false, scr, lane); }
    }
}
constexpr int L_QH = 0, L_KH = 17408, L_VB = 34816, L_KB = 52224, L_NM = 69632, L_TM = 87040, L_GS = 96256, L_BS = 96512;
DI bf16x8 tr_pair(const LAS unsigned char* lo, const LAS unsigned char* hi) {
    const s16x4 a = __builtin_amdgcn_ds_read_tr16_b64_v4i16((LAS s16x4*)lo), b = __builtin_amdgcn_ds_read_tr16_b64_v4i16((LAS s16x4*)hi);
    return __builtin_shufflevector(a, b, 0, 1, 2, 3, 4, 5, 6, 7);
}
DI bf16x8 ldsfrag_perm(const LAS unsigned char* rowp, int k0, int hh) {
    const u32x2 a = *(const LAS u32x2*)(rowp + 2 * (k0 + 4 * hh)), b = *(const LAS u32x2*)(rowp + 2 * (k0 + 8 + 4 * hh));
    u32x4 p; p[0] = a[0]; p[1] = a[1]; p[2] = b[0]; p[3] = b[1];
    return __builtin_bit_cast(bf16x8, p);
}
struct PrepRegs { u32x4 xr[11]; f32x4 w[8]; u32x4 fkv[2]; float pn0, pn1; };
DI void prep_loads(const Params& p, int task, int tid, int wid, int lane, PrepRegs& R) {
    const int bh = task / NCH, ch = task % NCH, b = bh >> 3, h = bh & 7;
    const bf16_t* proj = (const bf16_t*)(p.ws + WS_PROJ); const float* narrow = (const float*)(p.ws + WS_NARROW);
    const int nvalid = ch == 0 ? NMETA : 64, pbase = ch == 0 ? 0 : NMETA + 64 * (ch - 1);
    const int cgp = tid & 15, seg = (tid >> 4) & 7, m = __builtin_amdgcn_readfirstlane(tid >> 7);
    const int ch0 = m * 1024 + h * 128 + cgp * 8;
    if (m < 3) {
#pragma unroll
        for (int e = 0; e < 8; ++e) R.w[e] = *(const f32x4*)(p.conv_w + (size_t)(ch0 + e) * 4);
#pragma unroll
        for (int j = 0; j < 11; ++j) { const int i = 8 * seg - 3 + j, pp = pbase + i;
            R.xr[j] = (u32x4){0u, 0u, 0u, 0u};
            if (pp >= 0 && i < nvalid) R.xr[j] = *(const u32x4*)(proj + (size_t)rowof(b, pp) * NWIDE + ch0); }
    }
#pragma unroll
    for (int it = 0; it < 2; ++it) { const int item = tid + 512 * it, i = item >> 4;
        R.fkv[it] = (u32x4){0u, 0u, 0u, 0u};
        if (i < nvalid) R.fkv[it] = *(const u32x4*)(proj + (size_t)rowof(b, pbase + i) * NWIDE + COL_FK + h * 128 + (item & 15) * 8); }
    R.pn0 = 0.f; R.pn1 = 0.f;
    if (wid == 0 && lane < nvalid) { const float* nr = narrow + (size_t)rowof(b, pbase + lane) * 32; R.pn0 = nr[h]; R.pn1 = nr[8 + h]; }
}
DI void gdn_prep_task(const Params& p, LAS unsigned char* lds, int task, int next_task, int tid, int wid, int lane, PrepRegs& R) {
    const int bh = task / NCH, ch = task % NCH, b = bh >> 3, h = bh & 7;
    const size_t cb = (size_t)bh * NCH + ch;
    bf16_t* Ug = (bf16_t*)(p.ws + WS_U); bf16_t* Wg = (bf16_t*)(p.ws + WS_W); bf16_t* kdg = (bf16_t*)(p.ws + WS_KDT);
    bf16_t* qdg = (bf16_t*)((unsigned char*)p.out + DO_QD); bf16_t* aqkg = (bf16_t*)((unsigned char*)p.out + DO_AQK);
    LAS float* Nm = (LAS float*)(lds + L_NM); LAS bf16_t* Tm = (LAS bf16_t*)(lds + L_TM); LAS float* Gs = (LAS float*)(lds + L_GS); LAS float* Bs = (LAS float*)(lds + L_BS);
    const int nvalid = ch == 0 ? NMETA : 64, pbase = ch == 0 ? 0 : NMETA + 64 * (ch - 1);
    const int cgp = tid & 15, seg = (tid >> 4) & 7, m = __builtin_amdgcn_readfirstlane(tid >> 7);
    if (wid == 0) {
        float beta = 0.f, g = 0.f;
        if (lane < nvalid) { beta = sigmoidf_(R.pn0); g = -__expf(p.a_log[h]) * softplusf_(R.pn1 + p.dt_bias[h]); }
        const float G = scan64_dpp(g);
        Gs[lane] = G; Bs[lane] = beta;
        { const float eg = __expf(G), Gl0 = lane_bcast(G, 63); LAS float* Fs = (LAS float*)(lds + L_BS + 256);
          Fs[lane] = eg; Fs[64 + lane] = beta * eg; Fs[128 + lane] = __expf(Gl0 - G); }
    }
    __syncthreads();
    const float Gl = Gs[63];
    if (tid == 0) ((float*)(p.ws + WS_DECAY))[cb] = __expf(Gl);
#pragma unroll
    for (int it = 0; it < 2; ++it) { const int item = tid + 512 * it, i = item >> 4;
        float ss = 0.f;
#pragma unroll
        for (int e2 = 0; e2 < 4; ++e2) { const float lo = bflo(R.fkv[it][e2]), hi = bfhi(R.fkv[it][e2]); ss += lo * lo + hi * hi; }
        ss = sum16_dpp(ss);
        if ((item & 15) == 0 && i < nvalid) ((float*)(p.ws + WS_RK))[(size_t)bh * LP + pbase + i] = rsqrtf(ss * (1.f / HD) + EPSF); }
    auto conv_body = [&](auto MC) __attribute__((always_inline)) {
        constexpr int M = decltype(MC)::value;
        const LAS float* Fs = (const LAS float*)(lds + L_BS + 256) + 64 * (M == 0 ? 0 : 1);
        const LAS float* f1p = (M == 2 ? (const LAS float*)Bs : Fs) + 8 * seg;
        const f32x4 fa0 = *(const LAS f32x4*)f1p, fa1 = *(const LAS f32x4*)(f1p + 4);
        f32x4 fb0 = fa0, fb1 = fa1;
        if (M == 1) { fb0 = *(const LAS f32x4*)(f1p + 64); fb1 = *(const LAS f32x4*)(f1p + 68); }
        float xf[11][8];
#pragma unroll
        for (int j = 0; j < 11; ++j)
#pragma unroll
            for (int e2 = 0; e2 < 4; ++e2) { xf[j][2 * e2] = bflo(R.xr[j][e2]); xf[j][2 * e2 + 1] = bfhi(R.xr[j][e2]); }
#pragma unroll
        for (int u = 0; u < 8; ++u) {
            const int i = 8 * seg + u;
            float y[8];
#pragma unroll
            for (int e = 0; e < 8; ++e) y[e] = 0.f;
#pragma unroll
            for (int j = 0; j < 4; ++j)
#pragma unroll
                for (int e = 0; e < 8; ++e) y[e] += xf[u + j][e] * R.w[e][j];
            if (i >= nvalid) {
#pragma unroll
                for (int e = 0; e < 8; ++e) y[e] = 0.f;
            }
#pragma unroll
            for (int e = 0; e < 8; ++e) y[e] = siluf_(y[e]);
            const float fA = u < 4 ? fa0[u & 3] : fa1[u & 3], fB = u < 4 ? fb0[u & 3] : fb1[u & 3];
            if (M < 2) {
                float ss = 0.f;
#pragma unroll
                for (int e = 0; e < 8; ++e) ss += y[e] * y[e];
                ss = sum16_dpp(ss);
                const float rn = __builtin_amdgcn_rsqf(ss + EPSF) * (M == 0 ? 0.08838834764831845f : 1.f);
#pragma unroll
                for (int e = 0; e < 8; ++e) y[e] *= rn;
            }
            u32x4 o;
            if (M < 2) { o.x = pk2(y[0], y[1]); o.y = pk2(y[2], y[3]); o.z = pk2(y[4], y[5]); o.w = pk2(y[6], y[7]);
                *(LAS u32x4*)(lds + (M == 0 ? L_QH : L_KH) + i * 272 + cgp * 16) = o; }
            o.x = pk2(y[0] * fA, y[1] * fA); o.y = pk2(y[2] * fA, y[3] * fA); o.z = pk2(y[4] * fA, y[5] * fA); o.w = pk2(y[6] * fA, y[7] * fA);
            if (M == 0) *(u32x4*)(qdg + cb * 8192 + i * 128 + cgp * 8) = o;
            else *(LAS u32x4*)(lds + (M == 1 ? L_KB : L_VB) + i * 272 + cgp * 16) = o;
            if (M == 1) { o.x = pk2(y[0] * fB, y[1] * fB); o.y = pk2(y[2] * fB, y[3] * fB); o.z = pk2(y[4] * fB, y[5] * fB); o.w = pk2(y[6] * fB, y[7] * fB);
                *(u32x4*)(kdg + cb * 8192 + i * 128 + cgp * 8) = o; }
        }
    };
    if (m == 0) conv_body(std::integral_constant<int, 0>{}); else if (m == 1) conv_body(std::integral_constant<int, 1>{}); else if (m == 2) conv_body(std::integral_constant<int, 2>{});
    __syncthreads();
    const int r = lane & 31, hh = lane >> 5;
    const int i16 = lane & 15, tq = i16 >> 2, tp = i16 & 3, tblk = (lane >> 4) & 1;
    if (next_task >= 0) prep_loads(p, next_task, tid, wid, lane, R);
    for (int idx = tid; idx < 576; idx += 512) *(LAS u32x4*)(lds + L_TM + 16 * idx) = (u32x4){0u, 0u, 0u, 0u};
    {
        const bool isqk = wid >= 4; const int mi = (wid >> 1) & 1, ni = wid & 1;
        const LAS unsigned char* Ap = lds + (isqk ? L_QH : L_KH) + (32 * mi + r) * 272 + 16 * hh; const LAS unsigned char* Bp = lds + L_KH + (32 * ni + r) * 272 + 16 * hh;
        f32x16 acc;
#pragma unroll
        for (int t = 0; t < 16; ++t) acc[t] = 0.f;
#pragma unroll
        for (int ks = 0; ks < 8; ++ks) acc = MFMA32(*(const LAS bf16x8*)(Ap + 32 * ks), *(const LAS bf16x8*)(Bp + 32 * ks), acc);
        const int j = 32 * ni + r; const float Gj = Gs[j];
        const int i0 = 32 * mi + 4 * hh;
        if (!isqk) {
#pragma unroll
            for (int g = 0; g < 4; ++g) { const f32x4 Gi = *(const LAS f32x4*)(Gs + i0 + 8 * g), Bi = *(const LAS f32x4*)(Bs + i0 + 8 * g);
#pragma unroll
                for (int e = 0; e < 4; ++e) { const int i = i0 + 8 * g + e; Nm[i * 68 + j] = (j < i) ? Bi[e] * acc[4 * g + e] * __expf(Gi[e] - Gj) : 0.f; } }
        } else {
            bf16_t* ao = aqkg + cb * 4096 + j;
#pragma unroll
            for (int g = 0; g < 4; ++g) { const f32x4 Gi = *(const LAS f32x4*)(Gs + i0 + 8 * g);
#pragma unroll
                for (int e = 0; e < 4; ++e) { const int i = i0 + 8 * g + e; ao[i * 64] = (bf16_t)f2bf((j <= i) ? acc[4 * g + e] * __expf(Gi[e] - Gj) : 0.f); } }
        }
    }
    __syncthreads();
    if (wid == 0) {
        {
            const int blk = lane >> 4, c = lane & 15;
            float t[16];
            const LAS float* nb = Nm + (16 * blk) * 68 + 16 * blk;
#pragma unroll
            for (int i = 0; i < 16; ++i) {
                float a = (i == c) ? 1.f : 0.f, a2 = 0.f;
#pragma unroll
                for (int j4 = 0; j4 < (i + 3) / 4; ++j4) { const f32x4 nv = *(const LAS f32x4*)(nb + i * 68 + 4 * j4);
#pragma unroll
                    for (int e = 0; e < 4; ++e) if (4 * j4 + e < i) { if (e & 1) a2 -= nv[e] * t[4 * j4 + e]; else a -= nv[e] * t[4 * j4 + e]; } }
                a += a2;
                if ((i & 3) == 3) asm volatile("" : "+v"(a) :: "memory");
                t[i] = a;
            }
#pragma unroll
            for (int i = 0; i < 16; ++i) Tm[(16 * blk + i) * 72 + 16 * blk + c] = (bf16_t)f2bf(t[i]);
        }
        {
            const int half = r >> 4, rl = r & 15;
            const LAS float* np = Nm + (16 + 32 * half + rl) * 68 + 32 * half + 8 * hh;
            const f32x4 n0 = *(const LAS f32x4*)np, n1 = *(const LAS f32x4*)(np + 4);
            u32x4 ap; ap.x = pk2(n0[0], n0[1]); ap.y = pk2(n0[2], n0[3]); ap.z = pk2(n1[0], n1[1]); ap.w = pk2(n1[2], n1[3]);
            const LAS unsigned char* tb = lds + L_TM + (32 * tblk + 8 * hh + tq) * 144 + (32 * tblk + 4 * tp) * 2;
            f32x16 X1;
#pragma unroll
            for (int tt = 0; tt < 16; ++tt) X1[tt] = 0.f;
            X1 = MFMA32(__builtin_bit_cast(bf16x8, ap), tr_pair(tb, tb + 4 * 144), X1);
            const u32x4 x0 = __builtin_bit_cast(u32x4, pack8(X1, 0)), x1 = __builtin_bit_cast(u32x4, pack8(X1, 1));
            u32x4 xs; xs.x = half ? x1.x : x0.x; xs.y = half ? x1.y : x0.y; xs.z = half ? x1.z : x0.z; xs.w = half ? x1.w : x0.w;
            const LAS unsigned char* d1 = lds + L_TM + (16 + 32 * half + rl) * 144;
            f32x16 Y;
#pragma unroll
            for (int tt = 0; tt < 16; ++tt) Y[tt] = 0.f;
            Y = MFMA32(ldsfrag_perm(d1, 16 + 32 * half, hh), __builtin_bit_cast(bf16x8, xs), Y);
#pragma unroll
            for (int tt = 0; tt < 16; ++tt) { const int rowl = crow(tt, hh); if ((rowl >> 4) == half) Tm[(16 + 32 * half + (rowl & 15)) * 72 + 32 * half + rl] = (bf16_t)f2bf(-Y[tt]); }
        }
        f32x16 X;
#pragma unroll
        for (int tt = 0; tt < 16; ++tt) X[tt] = 0.f;
#pragma unroll
        for (int s2 = 0; s2 < 2; ++s2) {
            const LAS float* np = Nm + (32 + r) * 68 + 16 * s2 + 8 * hh;
            const f32x4 n0 = *(const LAS f32x4*)np, n1 = *(const LAS f32x4*)(np + 4);
            u32x4 ap; ap.x = pk2(n0[0], n0[1]); ap.y = pk2(n0[2], n0[3]); ap.z = pk2(n1[0], n1[1]); ap.w = pk2(n1[2], n1[3]);
            const LAS unsigned char* tb = lds + L_TM + (16 * s2 + 8 * hh + tq) * 144 + (16 * tblk + 4 * tp) * 2;
            X = MFMA32(__builtin_bit_cast(bf16x8, ap), tr_pair(tb, tb + 4 * 144), X);
        }
        f32x16 R;
#pragma unroll
        for (int tt = 0; tt < 16; ++tt) R[tt] = 0.f;
        const LAS unsigned char* t22 = lds + L_TM + (32 + r) * 144;
        R = MFMA32(ldsfrag_perm(t22, 32, hh), pack8(X, 0), R);
        R = MFMA32(ldsfrag_perm(t22, 48, hh), pack8(X, 1), R);
#pragma unroll
        for (int tt = 0; tt < 16; ++tt) Tm[(32 + crow(tt, hh)) * 72 + r] = (bf16_t)f2bf(-R[tt]);
    }
    __syncthreads();
#pragma unroll
    for (int q = 0; q < 2; ++q) {
        const int id = 2 * wid + q, X = id >> 3, mt = (id & 7) >> 1, nt = id & 1;
        const LAS unsigned char* img = lds + (X ? L_KB : L_VB) + (8 * hh + tq) * 272 + (32 * mt + 16 * tblk + 4 * tp) * 2;
        const LAS unsigned char* Bp = lds + L_TM + (32 * nt + r) * 144 + 16 * hh;
        f32x16 acc;
#pragma unroll
        for (int t = 0; t < 16; ++t) acc[t] = 0.f;
#pragma unroll
        for (int ks = 0; ks < 4; ++ks) { const bf16x8 fa = tr_pair(img + (16 * ks) * 272, img + (16 * ks + 4) * 272), fb = *(const LAS bf16x8*)(Bp + 32 * ks); acc = X ? MFMA32(fa, fb, acc) : MFMA32(fb, fa, acc); }
        bf16_t* dst = X ? Wg + cb * 8192 + (32 * nt + r) * 128 + 32 * mt + 4 * hh : Ug + cb * 8192 + (32 * mt + r) * 64 + 32 * nt + 4 * hh;
#pragma unroll
        for (int g = 0; g < 4; ++g) { u32x2 o; o[0] = pk2(acc[4 * g], acc[4 * g + 1]); o[1] = pk2(acc[4 * g + 2], acc[4 * g + 3]); *(u32x2*)(dst + 8 * g) = o; }
    }
    __syncthreads();
}
DI void fox_prep_task(const Params& p, LAS unsigned char* lds, int task, int tid) {
    const int bh = task / 33, tile = task % 33, b = bh >> 3, h = bh & 7, p0 = 64 * tile;
    const bf16_t* proj = (const bf16_t*)(p.ws + WS_PROJ);
    float* rk = (float*)(p.ws + WS_RK);
    u32x4 kv[2];
#pragma unroll
    for (int it = 0; it < 2; ++it) { const int item = tid + 512 * it, i = item >> 4, cgp = item & 15, pos = p0 + i;
        kv[it] = (u32x4){0u, 0u, 0u, 0u};
        if (pos < LTOT) kv[it] = *(const u32x4*)(proj + (size_t)rowof(b, pos) * NWIDE + COL_FK + h * 128 + cgp * 8); }
#pragma unroll
    for (int it = 0; it < 2; ++it) { const int item = tid + 512 * it, i = item >> 4, cgp = item & 15, pos = p0 + i;
        float ss = 0.f;
#pragma unroll
        for (int e2 = 0; e2 < 4; ++e2) { const float lo = bflo(kv[it][e2]), hi = bfhi(kv[it][e2]); ss += lo * lo + hi * hi; }
        ss = sum16_dpp(ss);
        if (cgp == 0) rk[(size_t)bh * LP + pos] = rsqrtf(ss * (1.f / HD) + EPSF); }
}
DI void cumsum_task(const Params& p, int bh, int lane) {
    const int b = bh >> 3, h = bh & 7; const float* narrow = (const float*)(p.ws + WS_NARROW); float* c2 = (float*)(p.ws + WS_C2);
    const float bias = p.f_bias[h]; float carry = 0.f;
    if (LTOT + lane < LP) ((float*)(p.ws + WS_RK))[(size_t)bh * LP + LTOT + lane] = 1.f;
    float xs[33];
#pragma unroll
    for (int k = 0; k < 33; ++k) { const int pos = 64 * k + lane; xs[k] = pos < LTOT ? narrow[(size_t)rowof(b, pos) * 32 + 16 + h] : 0.f; }
#pragma unroll
    for (int k = 0; k < 33; ++k) {
        const int pos = 64 * k + lane; float lf = 0.f;
        if (pos < LTOT) { const float xx = xs[k] + bias; lf = fminf(xx, 0.f) - __logf(1.f + __expf(-fabsf(xx))); }
        lf = scan64_dpp(lf);
        const float c = carry + lf; c2[(size_t)bh * LP + pos] = c * LOG2E; carry = lane_bcast(c, 63);
    }
}
DI void phase2(const Params& p, LAS unsigned char* lds, int tid, int wid, int lane) {
    constexpr int NG = 64 * NCH;
    const int G = gridDim.x;
    PrepRegs R;
    int t = blockIdx.x;
    if (t < NG) prep_loads(p, t, tid, wid, lane, R);
    if ((int)blockIdx.x >= G - 8) cumsum_task(p, ((int)blockIdx.x - (G - 8)) * 8 + wid, lane);
    for (; t < NG; t += G) {
        asm volatile("" : "+v"(tid)); wid = __builtin_amdgcn_readfirstlane(tid >> 6); lane = tid & 63;
        gdn_prep_task(p, lds, t, t + G < NG ? t + G : -1, tid, wid, lane, R);
    }
}
constexpr int SB_W = 0, SB_Q = 16896, SB_A = 33792, SB_K = 42496, SB_SIZE = 59904, S_OBUF = 2 * SB_SIZE;
DI void gdn_scan_task(const Params& p, LAS unsigned char* lds, int bh, int tid, int wid, int lane) {
    const int b = bh >> 3, h = bh & 7;
    const bf16_t* Ug = (const bf16_t*)(p.ws + WS_U); const bf16_t* Wg = (const bf16_t*)(p.ws + WS_W); const bf16_t* kdg = (const bf16_t*)(p.ws + WS_KDT);
    const bf16_t* qdg = (const bf16_t*)((const unsigned char*)p.out + DO_QD); const bf16_t* aqkg = (const bf16_t*)((const unsigned char*)p.out + DO_AQK);
    const float* decay = (const float*)(p.ws + WS_DECAY);
    const bf16_t* proj = (const bf16_t*)(p.ws + WS_PROJ); bf16_t* merged = (bf16_t*)((unsigned char*)p.out + DO_MERGED);
    LAS bf16_t* obuf16 = (LAS bf16_t*)(lds + S_OBUF);
    LAS float* gws = (LAS float*)(lds + S_OBUF + 34816);
    if (tid < 128) gws[tid] = p.gdn_norm_w[tid];
    const size_t cb0 = (size_t)bh * NCH;
    if (wid < 4) {
        const int sl = wid, r = lane & 31, hh = lane >> 5;
        const int i16 = lane & 15, tq = i16 >> 2, tp = i16 & 3, tblk = (lane >> 4) & 1;
        f32x16 S[4];
#pragma unroll
        for (int kt = 0; kt < 4; ++kt)
#pragma unroll
            for (int t = 0; t < 16; ++t) S[kt][t] = 0.f;
        u32x2 ureg[8]; float dec;
        { const bf16_t* Uc = Ug + cb0 * 8192 + (32 * sl + r) * 64 + 4 * hh;
#pragma unroll
          for (int q8 = 0; q8 < 8; ++q8) ureg[q8] = *(const u32x2*)(Uc + 32 * (q8 >> 2) + 8 * (q8 & 3));
          dec = decay[cb0]; }
        for (int c = 0; c <= NCH; ++c) {
            LDS_BARRIER();
            if (c == NCH) break;
            const LAS unsigned char* sb = lds + (c & 1) * SB_SIZE;
            const LAS unsigned char* rw0 = sb + SB_W + r * 264; const LAS unsigned char* rw1 = rw0 + 32 * 264;
            const LAS unsigned char* rq0 = sb + SB_Q + r * 264; const LAS unsigned char* rq1 = rq0 + 32 * 264;
            const LAS unsigned char* ra0 = sb + SB_A + r * 136; const LAS unsigned char* ra1 = ra0 + 32 * 136;
            const LAS unsigned char* kbase = sb + SB_K + (4 * hh + tq) * 272 + (16 * tblk + 4 * tp) * 2;
            bf16x8 fa[8], fb[8];
#define SBF(ks) pack8(S[(ks) >> 1], (ks) & 1)
#pragma unroll
            for (int k4 = 0; k4 < 4; ++k4) { fa[k4] = ldsfrag_perm(rw0, 16 * k4, hh); fa[4 + k4] = ldsfrag_perm(rw1, 16 * k4, hh); }
            CB();
#pragma unroll
            for (int k4 = 0; k4 < 4; ++k4) { fb[k4] = ldsfrag_perm(rw0, 64 + 16 * k4, hh); fb[4 + k4] = ldsfrag_perm(rw1, 64 + 16 * k4, hh); }
            f32x16 acc0, acc1, o0, o1;
#pragma unroll
            for (int t = 0; t < 16; ++t) { acc0[t] = 0.f; acc1[t] = 0.f; o0[t] = 0.f; o1[t] = 0.f; }
#pragma unroll
            for (int k4 = 0; k4 < 4; ++k4) { acc0 = MFMA32(fa[k4], SBF(k4), acc0); acc1 = MFMA32(fa[4 + k4], SBF(k4), acc1); }
            CB();
#pragma unroll
            for (int k4 = 0; k4 < 4; ++k4) { fa[k4] = ldsfrag_perm(rq0, 16 * k4, hh); fa[4 + k4] = ldsfrag_perm(rq1, 16 * k4, hh); }
#pragma unroll
            for (int k4 = 0; k4 < 4; ++k4) { acc0 = MFMA32(fb[k4], SBF(4 + k4), acc0); acc1 = MFMA32(fb[4 + k4], SBF(4 + k4), acc1); }
            CB();
#pragma unroll
            for (int k4 = 0; k4 < 4; ++k4) { fb[k4] = ldsfrag_perm(rq0, 64 + 16 * k4, hh); fb[4 + k4] = ldsfrag_perm(rq1, 64 + 16 * k4, hh); }
#pragma unroll
            for (int k4 = 0; k4 < 4; ++k4) { o0 = MFMA32(fa[k4], SBF(k4), o0); o1 = MFMA32(fa[4 + k4], SBF(k4), o1); }
            CB();
#pragma unroll
            for (int js = 0; js < 4; ++js) { if (js < 2) fa[js] = ldsfrag_perm(ra0, 16 * js, hh); fa[4 + js] = ldsfrag_perm(ra1, 16 * js, hh); }
#pragma unroll
            for (int k4 = 0; k4 < 4; ++k4) { o0 = MFMA32(fb[k4], SBF(4 + k4), o0); o1 = MFMA32(fb[4 + k4], SBF(4 + k4), o1); }
            f32x16 vn0, vn1;
#pragma unroll
            for (int g4 = 0; g4 < 4; ++g4) { const u32x2 u0 = ureg[g4], u1 = ureg[4 + g4];
                vn0[4 * g4] = bflo(u0[0]) - acc0[4 * g4]; vn0[4 * g4 + 1] = bfhi(u0[0]) - acc0[4 * g4 + 1]; vn0[4 * g4 + 2] = bflo(u0[1]) - acc0[4 * g4 + 2]; vn0[4 * g4 + 3] = bfhi(u0[1]) - acc0[4 * g4 + 3];
                vn1[4 * g4] = bflo(u1[0]) - acc1[4 * g4]; vn1[4 * g4 + 1] = bfhi(u1[0]) - acc1[4 * g4 + 1]; vn1[4 * g4 + 2] = bflo(u1[1]) - acc1[4 * g4 + 2]; vn1[4 * g4 + 3] = bfhi(u1[1]) - acc1[4 * g4 + 3]; }
            bf16x8 Vb[4];
            Vb[0] = pack8(vn0, 0); Vb[1] = pack8(vn0, 1); Vb[2] = pack8(vn1, 0); Vb[3] = pack8(vn1, 1);
            CB();
#pragma unroll
            for (int q8 = 0; q8 < 8; ++q8) { const LAS unsigned char* a0 = kbase + (16 * (q8 & 3)) * 272 + 64 * (q8 >> 2); fb[q8] = tr_pair(a0, a0 + 8 * 272); }
#pragma unroll
            for (int js = 0; js < 4; ++js) { if (js < 2) o0 = MFMA32(fa[js], Vb[js], o0); o1 = MFMA32(fa[4 + js], Vb[js], o1); }
            CB();
#pragma unroll
            for (int q8 = 0; q8 < 8; ++q8) { const LAS unsigned char* a0 = kbase + (16 * (q8 & 3)) * 272 + 64 * (2 + (q8 >> 2)); fa[q8] = tr_pair(a0, a0 + 8 * 272); }
            { f32x16 a0 = S[0] * dec, a1 = S[1] * dec;
#pragma unroll
              for (int js = 0; js < 4; ++js) { a0 = MFMA32(fb[js], Vb[js], a0); a1 = MFMA32(fb[4 + js], Vb[js], a1); }
              S[0] = a0; S[1] = a1; }
            CB();
            { f32x16 a2 = S[2] * dec, a3 = S[3] * dec;
#pragma unroll
              for (int js = 0; js < 4; ++js) { a2 = MFMA32(fa[js], Vb[js], a2); a3 = MFMA32(fa[4 + js], Vb[js], a3); }
              S[2] = a2; S[3] = a3; }
            if (c + 1 < NCH) {
                const bf16_t* Uc = Ug + (cb0 + c + 1) * 8192 + (32 * sl + r) * 64 + 4 * hh;
#pragma unroll
                for (int q8 = 0; q8 < 8; ++q8) ureg[q8] = *(const u32x2*)(Uc + 32 * (q8 >> 2) + 8 * (q8 & 3));
            }
            if (c + 1 < NCH) dec = decay[cb0 + c + 1];
            if (c > 0) {
                LAS bf16_t* ow = obuf16 + (c & 1) * (64 * 136) + 32 * sl + r;
#pragma unroll
                for (int t = 0; t < 16; ++t) { ow[crow(t, hh) * 136] = (bf16_t)f2bf(o0[t]); ow[(32 + crow(t, hh)) * 136] = (bf16_t)f2bf(o1[t]); }
            }
        }
    } else {
        const int lt = tid & 255, tok = lt >> 2, qtr = lt & 3;
        u32x4 lw[4], lq[4], lk[4], la[2], gz[4];
#define SCAN_LOAD_REGS(cbx) do { \
        _Pragma("unroll") for (int k = 0; k < 4; ++k) { const int id = lt + 256 * k, row = id >> 4, pc = id & 15; \
            lw[k] = *(const u32x4*)(Wg + (cbx) * 8192 + row * 128 + pc * 8); lq[k] = *(const u32x4*)(qdg + (cbx) * 8192 + row * 128 + pc * 8); lk[k] = *(const u32x4*)(kdg + (cbx) * 8192 + row * 128 + pc * 8); } \
        _Pragma("unroll") for (int k = 0; k < 2; ++k) { const int id = lt + 256 * k, row = id >> 3, pc = id & 7; la[k] = *(const u32x4*)(aqkg + (cbx) * 4096 + row * 64 + pc * 8); } \
    } while (0)
#define SCAN_STORE_REGS(sbx) do { \
        _Pragma("unroll") for (int k = 0; k < 4; ++k) { const int id = lt + 256 * k, row = id >> 4, pc = id & 15; \
            LAS u32x2* dw = (LAS u32x2*)((sbx) + SB_W + row * 264 + pc * 16); dw[0] = (u32x2){lw[k].x, lw[k].y}; dw[1] = (u32x2){lw[k].z, lw[k].w}; \
            LAS u32x2* dq = (LAS u32x2*)((sbx) + SB_Q + row * 264 + pc * 16); dq[0] = (u32x2){lq[k].x, lq[k].y}; dq[1] = (u32x2){lq[k].z, lq[k].w}; \
            *(LAS u32x4*)((sbx) + SB_K + row * 272 + pc * 16) = lk[k]; } \
        _Pragma("unroll") for (int k = 0; k < 2; ++k) { const int id = lt + 256 * k, row = id >> 3, pc = id & 7; \
            LAS u32x2* da = (LAS u32x2*)((sbx) + SB_A + row * 136 + pc * 16); da[0] = (u32x2){la[k].x, la[k].y}; da[1] = (u32x2){la[k].z, la[k].w}; } \
    } while (0)
        SCAN_LOAD_REGS(cb0);
        SCAN_STORE_REGS(lds);
        SCAN_LOAD_REGS(cb0 + 1);
#pragma unroll
        for (int e8 = 0; e8 < 4; ++e8) gz[e8] = (u32x4){0u, 0u, 0u, 0u};

        const LAS float* gw = gws + qtr * 32;
        for (int c = 0; c <= NCH; ++c) {
            LDS_BARRIER();
            if (c + 1 < NCH) { LAS unsigned char* sbn = lds + ((c + 1) & 1) * SB_SIZE; SCAN_STORE_REGS(sbn); }
            CB();
            if (c + 2 < NCH) SCAN_LOAD_REGS(cb0 + c + 2);
            CB();
            if (c >= 2) {
                const LAS u32x4* ob = (const LAS u32x4*)(obuf16 + ((c - 1) & 1) * (64 * 136) + tok * 136 + qtr * 32);
                u32x4 ov[4]; float ss = 0.f;
#pragma unroll
                for (int e8 = 0; e8 < 4; ++e8) { ov[e8] = ob[e8];
#pragma unroll
                    for (int e2 = 0; e2 < 4; ++e2) { const float lo = bflo(ov[e8][e2]), hi = bfhi(ov[e8][e2]); ss += lo * lo + hi * hi; } }
                ss = sum4_dpp(ss);
                const float rstd = __builtin_amdgcn_rsqf(ss * (1.f / HD) + EPSF);
                bf16_t* mp = merged + ((size_t)b * SEQ + 64 * (c - 2) + tok) * DM + h * 128 + qtr * 32;
#pragma unroll
                for (int e8 = 0; e8 < 4; ++e8) {
                    const f32x4 v0 = (f32x4){bflo(ov[e8].x), bfhi(ov[e8].x), bflo(ov[e8].y), bfhi(ov[e8].y)}, v1 = (f32x4){bflo(ov[e8].z), bfhi(ov[e8].z), bflo(ov[e8].w), bfhi(ov[e8].w)};
                    const f32x4 w0 = *(const LAS f32x4*)(gw + 8 * e8), w1 = *(const LAS f32x4*)(gw + 8 * e8 + 4);
                    const u32x4 g = gz[e8];
                    u32x4 o;
                    o.x = pk2(v0[0] * rstd * w0[0] * bflo(g.x), v0[1] * rstd * w0[1] * bfhi(g.x));
                    o.y = pk2(v0[2] * rstd * w0[2] * bflo(g.y), v0[3] * rstd * w0[3] * bfhi(g.y));
                    o.z = pk2(v1[0] * rstd * w1[0] * bflo(g.z), v1[1] * rstd * w1[1] * bfhi(g.z));
                    o.w = pk2(v1[2] * rstd * w1[2] * bflo(g.w), v1[3] * rstd * w1[3] * bfhi(g.w));
                    *(u32x4*)(mp + 8 * e8) = o;
                }
            }
            CB();
            if (c >= 1 && c < NCH) {
                const bf16_t* gzp = proj + ((size_t)b * SEQ + 64 * (c - 1) + tok) * NWIDE + COL_GZ + h * 128 + qtr * 32;
#pragma unroll
                for (int e8 = 0; e8 < 4; ++e8) gz[e8] = *(const u32x4*)(gzp + 8 * e8);
            }
        }
#undef SCAN_LOAD_REGS
#undef SCAN_STORE_REGS
    }
    __syncthreads();
}
constexpr int AB_K = 0, AB_V = 17408, AB_C = 34816, AB_R = 35072, AB_SIZE = 35328;
DI void attn_task(const Params& p, LAS unsigned char* lds, int a, int tid, int wid, int lane) {
    const int qblk = 7 - (a >> 6), bh = a & 63, b = bh >> 3, h = bh & 7, r = lane & 31, hh = lane >> 5;
    const bf16_t* proj = (const bf16_t*)(p.ws + WS_PROJ); bf16_t* merged = (bf16_t*)((unsigned char*)p.out + DO_MERGED);
    const int qs = NMETA + 256 * qblk + 32 * wid, qpos = qs + r;
    const size_t row = (size_t)b * SEQ + 256 * qblk + 32 * wid + r;
    const int nT = (271 + 256 * qblk) / 64 + 1;
    const int i16 = lane & 15, tq = i16 >> 2, tp = i16 & 3, tblk = (lane >> 4) & 1;
    u32x4 pk[2], pv[2]; f32x4 pc4 = (f32x4){0.f, 0.f, 0.f, 0.f};
    const float* cbp = (const float*)(p.ws + WS_C2) + (size_t)bh * LP;
    const float* rkp = (const float*)(p.ws + WS_RK) + (size_t)bh * LP;
    float prk[2];
#define ATT_LOAD(j) do { if (tid < 16) pc4 = *(const f32x4*)(cbp + 64 * (j) + 4 * tid); \
        _Pragma("unroll") for (int k = 0; k < 2; ++k) { const int id = tid + 512 * k; int pos = 64 * (j) + (id >> 4); pos = pos < LTOT ? pos : LTOT - 1; \
        const bf16_t* rp = proj + (size_t)rowof(b, pos) * NWIDE + h * 128 + (id & 15) * 8; \
        pk[k] = *(const u32x4*)(rp + COL_FK); pv[k] = *(const u32x4*)(rp + COL_FV); prk[k] = rkp[pos]; } } while (0)
#define ATT_STORE(bufp) do { if (tid < 16) *(LAS f32x4*)((bufp) + AB_C + 16 * tid) = pc4; _Pragma("unroll") for (int k = 0; k < 2; ++k) { const int id = tid + 512 * k; \
        u32x4 kq; const float rs = prk[k];   \
        kq.x = pk2(bflo(pk[k].x) * rs, bfhi(pk[k].x) * rs); kq.y = pk2(bflo(pk[k].y) * rs, bfhi(pk[k].y) * rs); kq.z = pk2(bflo(pk[k].z) * rs, bfhi(pk[k].z) * rs); kq.w = pk2(bflo(pk[k].w) * rs, bfhi(pk[k].w) * rs); \
        *(LAS u32x4*)((bufp) + AB_K + (id >> 4) * 272 + (id & 15) * 16) = kq; *(LAS u32x4*)((bufp) + AB_V + (id >> 4) * 272 + (id & 15) * 16) = pv[k]; } } while (0)
    u32x4 gl[8];
    { const bf16_t* gsrc = proj + ((size_t)b * SEQ + 256 * qblk + (tid >> 1)) * NWIDE + COL_FG + h * 128 + (tid & 1) * 64;
#pragma unroll
      for (int i = 0; i < 8; ++i) gl[i] = *(const u32x4*)(gsrc + 8 * i); }
    ATT_LOAD(nT - 1);
    const bf16_t* qp = proj + row * NWIDE + COL_FQ + h * 128 + 8 * hh;
    u32x4 qraw[8]; float ss = 0.f;
#pragma unroll
    for (int ks = 0; ks < 8; ++ks) qraw[ks] = *(const u32x4*)(qp + 16 * ks);
    CB();
    { LAS unsigned char* gdst = lds + 2 * AB_SIZE + (tid >> 1) * 264 + (tid & 1) * 128;
#pragma unroll
      for (int i = 0; i < 8; ++i) { LAS u32x2* d2 = (LAS u32x2*)(gdst + 16 * i); d2[0] = (u32x2){gl[i].x, gl[i].y}; d2[1] = (u32x2){gl[i].z, gl[i].w}; } }
    CB();
#pragma unroll
    for (int ks = 0; ks < 8; ++ks) {
#pragma unroll
        for (int e = 0; e < 4; ++e) { const float lo = bflo(qraw[ks][e]), hi = bfhi(qraw[ks][e]); ss += lo * lo + hi * hi; } }
    ss = xhalf_sum(ss);
    const float qsc = rsqrtf(ss * (1.f / HD) + EPSF);
    const LAS float* qw = (const LAS float*)(lds + L_QW);
    bf16x8 Qb[8];
#pragma unroll
    for (int ks = 0; ks < 8; ++ks) { const f32x4 w0 = *(const LAS f32x4*)(qw + 16 * ks + 8 * hh), w1 = *(const LAS f32x4*)(qw + 16 * ks + 8 * hh + 4);
        u32x4 o; o.x = pk2(bflo(qraw[ks].x) * qsc * w0[0], bfhi(qraw[ks].x) * qsc * w0[1]); o.y = pk2(bflo(qraw[ks].y) * qsc * w0[2], bfhi(qraw[ks].y) * qsc * w0[3]);
        o.z = pk2(bflo(qraw[ks].z) * qsc * w1[0], bfhi(qraw[ks].z) * qsc * w1[1]); o.w = pk2(bflo(qraw[ks].w) * qsc * w1[2], bfhi(qraw[ks].w) * qsc * w1[3]);
        Qb[ks] = __builtin_bit_cast(bf16x8, o); }
    f32x16 O[4];
#pragma unroll
    for (int dt = 0; dt < 4; ++dt)
#pragma unroll
        for (int t = 0; t < 16; ++t) O[dt][t] = 0.f;
    float m = -INFINITY, l = 0.f;
    ATT_STORE(lds);
    __syncthreads();
    for (int it = 0; it < nT; ++it) {
        const int j = nT - 1 - it;
        const LAS unsigned char* buf = lds + (it & 1) * AB_SIZE;
        if (it + 1 < nT) ATT_LOAD(j - 1);
#pragma unroll
        for (int stt = 0; stt < 2; ++stt) {
            const int st = 1 - stt;
            const int kb = 64 * j + 32 * st;
            if (kb <= qs + 31) {
                f32x16 s;
#pragma unroll
                for (int t = 0; t < 16; ++t) s[t] = 0.f;
                const LAS unsigned char* kp = buf + AB_K + (32 * st + r) * 272 + 16 * hh;
                bf16x8 kf[4], vf[4];
#pragma unroll
                for (int ks = 0; ks < 4; ++ks) kf[ks] = *(const LAS bf16x8*)(kp + 32 * ks);
                CB();
#pragma unroll
                for (int ks = 0; ks < 4; ++ks) s = MFMA32(kf[ks], Qb[ks], s);
#pragma unroll
                for (int ks = 0; ks < 4; ++ks) kf[ks] = *(const LAS bf16x8*)(kp + 128 + 32 * ks);
                CB();
#pragma unroll
                for (int ks = 0; ks < 4; ++ks) s = MFMA32(kf[ks], Qb[4 + ks], s);
                const LAS unsigned char* vp0 = buf + AB_V + (32 * st + 4 * hh + tq) * 272 + (16 * tblk + 4 * tp) * 2;
#pragma unroll
                for (int dt = 0; dt < 2; ++dt) { const LAS unsigned char* vp = vp0 + 64 * dt; vf[2 * dt] = tr_pair(vp, vp + 8 * 272); vf[2 * dt + 1] = tr_pair(vp + 16 * 272, vp + 24 * 272); }
                CB();
                const bool needmask = (kb + 31 > qs);
                float mx = -INFINITY;
#pragma unroll
                for (int g = 0; g < 4; ++g) { const f32x4 nb4 = -*(const LAS f32x4*)(buf + AB_C + 4 * (32 * st + 8 * g + 4 * hh));
                    if (needmask) {
#pragma unroll
                        for (int e = 0; e < 4; ++e) { float v = s[4 * g + e] + nb4[e]; if (kb + 8 * g + 4 * hh + e > qpos) v = -INFINITY; s[4 * g + e] = v; mx = fmaxf(mx, v); }
                    } else {
#pragma unroll
                        for (int e = 0; e < 4; ++e) { const float v = s[4 * g + e] + nb4[e]; s[4 * g + e] = v; mx = fmaxf(mx, v); }
                    } }
                mx = xhalf_max(mx);
                const float mn = fmaxf(m, mx);
                const float mref = (mn == -INFINITY) ? 0.f : mn;
                const float alpha = __builtin_amdgcn_exp2f(m - mref);
                float ps = 0.f;
#pragma unroll
                for (int t = 0; t < 16; ++t) { const float pv_ = __builtin_amdgcn_exp2f(s[t] - mref); s[t] = pv_; ps += pv_; }
                m = mn;
                if (__builtin_amdgcn_ballot_w64(alpha != 1.f) != 0ull) {
                    l = l * alpha + ps;
#pragma unroll
                    for (int dt = 0; dt < 4; ++dt) O[dt] = O[dt] * alpha;
                } else l += ps;
                const bf16x8 P0 = pack8(s, 0), P1 = pack8(s, 1);
                bf16x8 vg[4];
#pragma unroll
                for (int dt = 0; dt < 2; ++dt) { const LAS unsigned char* vp = vp0 + 64 * (2 + dt); vg[2 * dt] = tr_pair(vp, vp + 8 * 272); vg[2 * dt + 1] = tr_pair(vp + 16 * 272, vp + 24 * 272); }
#pragma unroll
                for (int dt = 0; dt < 2; ++dt) { O[dt] = MFMA32(vf[2 * dt], P0, O[dt]); O[dt] = MFMA32(vf[2 * dt + 1], P1, O[dt]); }
                CB();
#pragma unroll
                for (int dt = 0; dt < 2; ++dt) { O[2 + dt] = MFMA32(vg[2 * dt], P0, O[2 + dt]); O[2 + dt] = MFMA32(vg[2 * dt + 1], P1, O[2 + dt]); }
            }
        }
        if (it + 1 < nT) { LAS unsigned char* nb = lds + ((it + 1) & 1) * AB_SIZE; ATT_STORE(nb); }
        __syncthreads();
    }
#undef ATT_LOAD
#undef ATT_STORE
    l = xhalf_sum(l);
    const float inv = __builtin_amdgcn_rcpf(l);
    bf16_t* mp = merged + row * DM + 1024 + h * 128 + 4 * hh;
    const LAS unsigned char* gp = lds + 2 * AB_SIZE + (32 * wid + r) * 264 + 8 * hh;
    u32x2 gzs[16];
#pragma unroll
    for (int i = 0; i < 16; ++i) gzs[i] = *(const LAS u32x2*)(gp + 64 * (i >> 2) + 16 * (i & 3));
#pragma unroll
    for (int dt = 0; dt < 4; ++dt)
#pragma unroll
        for (int g = 0; g < 4; ++g) { const u32x2 gz = gzs[4 * dt + g];
            u32x2 o; o[0] = pk2(O[dt][4 * g] * inv * bflo(gz[0]), O[dt][4 * g + 1] * inv * bfhi(gz[0]));
            o[1] = pk2(O[dt][4 * g + 2] * inv * bflo(gz[1]), O[dt][4 * g + 3] * inv * bfhi(gz[1]));
            *(u32x2*)(mp + 32 * dt + 8 * g) = o; }
}
DI void phase3(const Params& p, LAS unsigned char* lds, int tid, int wid, int lane, int rep) {
    LAS int* stask = (LAS int*)(lds + LDS_BYTES - 16);
    unsigned* ctr = (unsigned*)(p.ws + WS_CTR) + rep;
    if (tid < 128) ((LAS float*)(lds + L_QW))[tid] = p.fq_w[tid] * p.fk_w[tid] * (0.08838834764831845f * LOG2E);
    if (tid == 0) stask[0] = (int)atomicAdd(ctr, 1u);
    __syncthreads();
    int t = stask[0];
    __syncthreads();
    while (t < 64 + 512) {
        asm volatile("" : "+v"(tid)); wid = __builtin_amdgcn_readfirstlane(tid >> 6); lane = tid & 63;
        if (t < 64) gdn_scan_task(p, lds, t, tid, wid, lane);
        else attn_task(p, lds, t - 64, tid, wid, lane);
        if (tid == 0) stask[0] = (int)atomicAdd(ctr, 1u);
        __syncthreads();
        t = stask[0];
        __syncthreads();
    }
}
DI void phase5(const Params& p, int gw, int ngw, int lane) {
    const bf16_t* ob = (const bf16_t*)(p.ws + WS_OUT);
    f32x4 w[8];
#pragma unroll
    for (int j = 0; j < 8; ++j) w[j] = ((const f32x4*)p.post_w)[lane + 64 * j];
    for (int row = gw; row < MR; row += ngw) {
        const u32x2* src = (const u32x2*)(ob + (size_t)row * DM); const f32x4* xs = (const f32x4*)(p.x + (size_t)row * DM);
        u32x2 vb[8]; f32x4 xv[8]; float ss = 0.f;
#pragma unroll
        for (int j = 0; j < 8; ++j) { vb[j] = __builtin_nontemporal_load(src + lane + 64 * j); xv[j] = __builtin_nontemporal_load(xs + lane + 64 * j); }
        CB();
        f32x4 v[8];
#pragma unroll
        for (int j = 0; j < 8; ++j) { v[j] = (f32x4){bflo(vb[j][0]), bfhi(vb[j][0]), bflo(vb[j][1]), bfhi(vb[j][1])}; ss += v[j][0] * v[j][0] + v[j][1] * v[j][1] + v[j][2] * v[j][2] + v[j][3] * v[j][3]; }
        ss = wave_sum(ss);
        const float rstd = rsqrtf(ss * (1.f / DM) + EPSF);
#pragma unroll
        for (int j = 0; j < 8; ++j) __builtin_nontemporal_store(xv[j] + v[j] * rstd * w[j], (f32x4*)(p.out + (size_t)row * DM) + lane + 64 * j);
    }
}

#define XB_TMO      128
#define XB_XCNT(j)  (256  + 64 * (j))
#define XB_XSUB(j)  (1280 + 64 * (j))
#define XB_XGEN(j)  (2304 + 64 * (j))
#define XB_TOP      3328
#define XB_TOPGEN   3392
#define XCD_BAR_WORDS 3456
#define XB_SPIN_CAP (1u << 18)

__device__ __forceinline__ unsigned xb_ld(unsigned* p)              { return __hip_atomic_load(p, __ATOMIC_RELAXED, __HIP_MEMORY_SCOPE_AGENT); }
__device__ __forceinline__ unsigned xb_add(unsigned* p, unsigned v) { return __hip_atomic_fetch_add(p, v, __ATOMIC_RELAXED, __HIP_MEMORY_SCOPE_AGENT); }
__device__ __forceinline__ unsigned xb_xcc_id() { return (unsigned)__builtin_amdgcn_s_getreg((3 << 11) | 20) & 0xFu; }
#define XB_SPIN(cond, bar) do { unsigned _sp = 0; while (cond) { __builtin_amdgcn_s_sleep(1); \
    if ((++_sp & 255u) == 0u) { if (xb_ld(&(bar)[XB_TMO])) break; if (_sp > XB_SPIN_CAP) { atomicAdd(&(bar)[XB_TMO], 1u); break; } } } } while (0)

struct XcdBarrier {
    unsigned* bar; unsigned x;
    volatile LAS unsigned* st;
};

__device__ __forceinline__ XcdBarrier xcd_barrier_post(unsigned* bar, volatile LAS unsigned* st) {
    XcdBarrier b; b.bar = bar; b.x = xb_xcc_id(); b.st = st;
    if (threadIdx.x == 0) (void)xb_add(&bar[XB_XCNT(b.x)], 1u);
    return b;
}
__device__ __forceinline__ void xcd_barrier_complete(unsigned* bar, unsigned x, unsigned& nloc, unsigned& nx) {
    const unsigned G = gridDim.x * gridDim.y * gridDim.z;
    unsigned sum, cnt, mine, sp = 0u;
    for (;;) {
        sum = 0u; cnt = 0u; mine = 0u;
#pragma unroll
        for (unsigned j = 0; j < 16; ++j) { const unsigned c = xb_ld(&bar[XB_XCNT(j)]); sum += c; cnt += (c > 0u) ? 1u : 0u; mine = (j == x) ? c : mine; }
        if (sum == G) break;
        __builtin_amdgcn_s_sleep(1);
        if ((++sp & 255u) == 0u) { if (xb_ld(&bar[XB_TMO])) break; if (sp > XB_SPIN_CAP) { atomicAdd(&bar[XB_TMO], 1u); break; } }
    }
    nloc = mine > 0u ? mine : 1u; nx = cnt > 0u ? cnt : 1u;
}

__device__ __forceinline__ void xcd_barrier(const XcdBarrier& b) {
    asm volatile("s_waitcnt vmcnt(0)" ::: "memory");
    __syncthreads();
    if (threadIdx.x == 0) {
        unsigned* bar = b.bar;
        __builtin_amdgcn_s_waitcnt(0);
        unsigned nloc = b.st[0], nx = b.st[1];
        if (nloc == 0u) { xcd_barrier_complete(bar, b.x, nloc, nx); b.st[0] = nloc; b.st[1] = nx; }
        const unsigned old = xb_add(&bar[XB_XSUB(b.x)], 1u);
        const unsigned gen = old / nloc;
        if (old + 1u == (gen + 1u) * nloc) {
            __builtin_amdgcn_fence(__ATOMIC_RELEASE, "agent");
            asm volatile("s_waitcnt vmcnt(0)" ::: "memory");
            const unsigned og = xb_add(&bar[XB_TOP], 1u);
            const unsigned tg = og / nx;
            if (og + 1u == (tg + 1u) * nx) xb_add(&bar[XB_TOPGEN], 1u);
            else XB_SPIN(xb_ld(&bar[XB_TOPGEN]) == tg, bar);
            __builtin_amdgcn_fence(__ATOMIC_ACQUIRE, "agent");
            xb_add(&bar[XB_XGEN(b.x)], 1u);
            asm volatile("s_waitcnt vmcnt(0)" ::: "memory");
        } else {
            XB_SPIN(xb_ld(&bar[XB_XGEN(b.x)]) == gen, bar);
            __builtin_amdgcn_fence(__ATOMIC_ACQUIRE, "agent");
            asm volatile("s_waitcnt vmcnt(0)" ::: "memory");
        }
    }
    __syncthreads();
}


DI void grid_barrier(unsigned* ctr, unsigned target) {
    asm volatile("s_waitcnt vmcnt(0) lgkmcnt(0)" ::: "memory");
    __syncthreads();
    if (threadIdx.x == 0) {
        __builtin_amdgcn_fence(__ATOMIC_RELEASE, "agent");
        asm volatile("s_waitcnt vmcnt(0)" ::: "memory");
        __hip_atomic_fetch_add(ctr, 1u, __ATOMIC_RELAXED, __HIP_MEMORY_SCOPE_AGENT);
        while (__hip_atomic_load(ctr, __ATOMIC_RELAXED, __HIP_MEMORY_SCOPE_AGENT) < target) __builtin_amdgcn_s_sleep(2);
        __builtin_amdgcn_fence(__ATOMIC_ACQUIRE, "agent");
        asm volatile("s_waitcnt vmcnt(0)" ::: "memory");
    }
    __syncthreads();
}
__global__ void __launch_bounds__(512, 2) hymba_fwd(Params p) {
    extern __shared__ __attribute__((aligned(16))) unsigned char smem[];
    LAS unsigned char* lds = (LAS unsigned char*)smem;
    cg::grid_group grid = cg::this_grid();
    unsigned* gbar = (unsigned*)(p.ws + WS_BAR);
    volatile LAS unsigned* xst = (volatile LAS unsigned*)(lds + LDS_BYTES - 32);
    if (threadIdx.x == 0) { xst[0] = 0u; xst[1] = 0u; }
    __syncthreads();
    const XcdBarrier xbar = xcd_barrier_post(gbar, xst);
    if (p.ws == nullptr) grid.sync();
    int tid = threadIdx.x, wid, lane;
    const int wid0 = __builtin_amdgcn_readfirstlane((int)threadIdx.x >> 6);
#define RELOAD_IDS() do { tid = threadIdx.x; asm volatile("" : "+v"(tid)); wid = __builtin_amdgcn_readfirstlane(tid >> 6); lane = tid & 63; } while (0)
#define RELOAD_IDS2() do { lane = __builtin_amdgcn_mbcnt_hi(~0u, __builtin_amdgcn_mbcnt_lo(~0u, 0u)); wid = wid0; tid = wid0 * 64 + lane; asm volatile("" : "+v"(tid)); } while (0)
    RELOAD_IDS();
    phase0(p, lds, tid, wid, lane);
    xcd_barrier(xbar);
    for (int rep = 0; rep < REP1; ++rep) { if (rep) grid.sync();
    { pg8::Gemm g; g.A = (const bf16_t*)(p.ws + WS_XN); g.Bt = (const bf16_t*)(p.ws + WS_WINT); g.M = MPAD; g.N = NPAD; g.K = DM;
      pg8::StaticOrder S; S.init(MPAD, NPAD, gridDim.x, blockIdx.x);
      EpiProj E; E.P = (bf16_t*)(p.ws + WS_PROJ); E.narrow = (float*)(p.ws + WS_NARROW);
      pg8::gemm_phase<EpiProj, pg8::StaticOrder, true, true>(lds, g, S, E, tid); } }
    xcd_barrier(xbar);
    for (int rep = 0; rep < REP2; ++rep) { if (rep) grid.sync();
    RELOAD_IDS();
    phase2(p, lds, tid, wid, lane); }
    xcd_barrier(xbar);
    for (int rep = 0; rep < REP3; ++rep) { if (rep) grid.sync();
    RELOAD_IDS();
    phase3(p, lds, tid, wid, lane, rep); }
    xcd_barrier(xbar);
    { pg8::Gemm g; g.A = (const bf16_t*)((const unsigned char*)p.out + DO_MERGED); g.Bt = (const bf16_t*)(p.ws + WS_WOUTT); g.M = MR; g.N = DM; g.K = DM;
      pg8::StaticOrder S; S.init(MR, DM, gridDim.x, blockIdx.x);
      EpiOut E; E.C = (bf16_t*)(p.ws + WS_OUT);
      RELOAD_IDS2();
      pg8::gemm_phase<EpiOut, pg8::StaticOrder, true, true>(lds, g, S, E, tid); }
    xcd_barrier(xbar);
    RELOAD_IDS2();
    phase5(p, blockIdx.x * 8 + wid, gridDim.x * 8, lane);
}

extern "C" void kernel_launch(void* const* d_in, const int* in_sizes, int n_in, void* d_out, int out_size, void* d_ws, size_t ws_size, hipStream_t stream) {
    static int grid_blocks = 0;
    if (!grid_blocks) {
        int dev = 0, cus = 0, per_cu = 0;
        hipGetDevice(&dev);
        hipDeviceGetAttribute(&cus, hipDeviceAttributeMultiprocessorCount, dev);
        hipFuncSetAttribute((const void*)hymba_fwd, hipFuncAttributeMaxDynamicSharedMemorySize, LDS_BYTES);
        hipOccupancyMaxActiveBlocksPerMultiprocessor(&per_cu, (const void*)hymba_fwd, 512, LDS_BYTES);
        if (per_cu < 1) per_cu = 1;
        grid_blocks = cus;
        if (ws_size < WS_END) fprintf(stderr, "kernel_launch: workspace too small: %zu < %zu\n", ws_size, (size_t)WS_END);
    }
    Params p{};
    p.x = (const float*)d_in[0]; p.meta = (const float*)d_in[1]; p.pre_w = (const float*)d_in[2]; p.w_in = (const float*)d_in[3]; p.conv_w = (const float*)d_in[4];
    p.a_log = (const float*)d_in[5]; p.dt_bias = (const float*)d_in[6]; p.gdn_norm_w = (const float*)d_in[7]; p.fq_w = (const float*)d_in[8]; p.fk_w = (const float*)d_in[9];
    p.f_bias = (const float*)d_in[10]; p.w_out = (const float*)d_in[11]; p.post_w = (const float*)d_in[12];
    p.out = (float*)d_out; p.ws = (unsigned char*)d_ws;
    (void)hipMemsetAsync((unsigned char*)d_ws + WS_BAR, 0, 16384, stream);
    void* args[] = {&p};
    hipError_t e = hipLaunchCooperativeKernel((const void*)hymba_fwd, dim3(grid_blocks), dim3(512), args, LDS_BYTES, stream);
    if (e != hipSuccess) fprintf(stderr, "cooperative launch failed: %s (grid %d)\n", hipGetErrorString(e), grid_blocks);
}
```
